# Optimizing an MI355X kernel written in HIP

```python
import math
import jax
import jax.numpy as jnp
from jax import lax
import numpy as np


D_MODEL = 2048
BATCH = 32
SEQ = 256
DEPTH = 2
DEC_BATCH = 2
DEC_SEQ = 4096
PAST_LEN = 256

GRID_W = 64
QBLOCK = 128
CHUNK = 128
ROPE_THETA = 10000.0
EPS = 1e-6

A_GROUPS = 8
A_GROUP_CH = 128
A_WIDTH = A_GROUPS * A_GROUP_CH
B_HEADS = 8
B_KV_HEADS = 2
B_HEAD_DIM = 128
B_GROUP = B_HEADS // B_KV_HEADS
B_WIDTH = B_HEADS * B_HEAD_DIM
B_KV_WIDTH = B_KV_HEADS * B_HEAD_DIM
IN0_WIDTH = 3 * A_WIDTH + 2 * B_WIDTH + 2 * B_KV_WIDTH
OUT0_WIDTH = A_WIDTH + B_WIDTH
C_HEADS = 16
C_QK_DIM = 64
C_V_DIM = 2 * C_QK_DIM
C_QK_WIDTH = C_HEADS * 2 * C_QK_DIM
C_V_WIDTH = C_HEADS * C_V_DIM
IN1_WIDTH = 2 * C_QK_WIDTH + 2 * C_V_WIDTH
LAMBDA_INIT_1 = 0.8 - 0.6 * math.exp(-0.3 * 1)

kernel_name = "hybrid_gmlp_gqa_diffattn_dit_step"

F32 = jnp.float32


def rms_norm(x, g):
    xf = x.astype(F32)
    xf = xf * lax.rsqrt(jnp.mean(xf * xf, axis=-1, keepdims=True) + EPS)
    return (xf * g.astype(F32)).astype(x.dtype)


def ada_modulate(x, cond, w_ada, b_ada, norm_g):
    mod = jax.nn.silu(cond) @ w_ada + b_ada
    if mod.ndim == 1:
        mod = mod[None]
    shift, scale, gate = jnp.split(mod[:, None, :], 3, axis=-1)
    h = rms_norm(x, norm_g) * (1 + scale) + shift
    return h, gate


def rope_1d(x, pos):
    half = x.shape[-1] // 2
    freqs = ROPE_THETA ** (-jnp.arange(half, dtype=F32) / half)
    ang = pos[:, None] * freqs[None, :]
    shp = (pos.shape[0],) + (1,) * (x.ndim - 3) + (half,)
    cos = jnp.cos(ang).reshape(shp)
    sin = jnp.sin(ang).reshape(shp)
    xf = x.astype(F32)
    x1, x2 = xf[..., :half], xf[..., half:]
    return jnp.concatenate([x1 * cos - x2 * sin, x1 * sin + x2 * cos], axis=-1).astype(x.dtype)


def rope_2d(x, row, col):
    h = x.shape[-1] // 2
    return jnp.concatenate([rope_1d(x[..., :h], row), rope_1d(x[..., h:], col)], axis=-1)


def over_query_blocks(fn, q):
    b_, t = q.shape[0], q.shape[1]
    nb = t // QBLOCK
    qb = jnp.moveaxis(q.reshape((b_, nb, QBLOCK) + q.shape[2:]), 1, 0)
    out = lax.map(fn, qb)
    return jnp.moveaxis(out, 0, 1).reshape((b_, t) + out.shape[3:])


def gqa_attend(q, k, v):
    scale = B_HEAD_DIM ** -0.5

    def block(qb):
        s = jnp.einsum('bqhgd,bshd->bhgqs', qb, k).astype(F32) * scale
        p = jax.nn.softmax(s, axis=-1).astype(v.dtype)
        return jnp.einsum('bhgqs,bshd->bqhgd', p, v)

    return over_query_blocks(block, q)


def diff_attend(q, k, v, lam):
    scale = C_QK_DIM ** -0.5

    def block(qb):
        s = jnp.einsum('bqhmd,bshmd->bhmqs', qb, k).astype(F32) * scale
        p = jax.nn.softmax(s, axis=-1)
        w = (p[:, :, 0] - lam * p[:, :, 1]).astype(v.dtype)
        return jnp.einsum('bhqs,bshe->bqhe', w, v)

    return over_query_blocks(block, q)


def chunk_spatial_gate(u, v, w_s, b_s):
    b_, t = u.shape[0], u.shape[1]
    n = t // CHUNK
    vf = v.astype(F32)
    mu = jnp.mean(vf, axis=-1, keepdims=True)
    var = jnp.mean((vf - mu) ** 2, axis=-1, keepdims=True)
    vn = ((vf - mu) * lax.rsqrt(var + EPS)).astype(v.dtype)
    vc = vn.reshape(b_, n, CHUNK, A_GROUPS, A_GROUP_CH)
    s = jnp.einsum('gpq,bnqgc->bnpgc', w_s, vc) + b_s.T[None, None, :, :, None]
    return u * s.reshape(b_, t, A_WIDTH)


def mixer_ab(h, w_in, w_s, b_s, q_g, k_g, w_out, pos, ctx_k, ctx_v):
    b_, t = h.shape[0], h.shape[1]
    z = h @ w_in
    idx = np.cumsum([A_WIDTH, A_WIDTH, A_WIDTH, B_WIDTH, B_KV_WIDTH, B_KV_WIDTH]).tolist()
    u_a, v_a, g_a, q, k, v, g_b = jnp.split(z, idx, axis=-1)
    y_a = chunk_spatial_gate(u_a, v_a, w_s, b_s) * jax.nn.silu(g_a)
    q = rms_norm(q.reshape(b_, t, B_KV_HEADS, B_GROUP, B_HEAD_DIM), q_g)
    k = rms_norm(k.reshape(b_, t, B_KV_HEADS, B_HEAD_DIM), k_g)
    v = v.reshape(b_, t, B_KV_HEADS, B_HEAD_DIM)
    if pos is None:
        qr, k_all, v_all = q, k, v
    else:
        row, col = pos
        qr = rope_2d(q, row, col)
        k_all = jnp.concatenate([rope_2d(k, row, col), ctx_k], axis=1)
        v_all = jnp.concatenate([v, ctx_v], axis=1)
    y_b = gqa_attend(qr, k_all, v_all).reshape(b_, t, B_WIDTH) * jax.nn.silu(g_b)
    out = jnp.concatenate([y_a, y_b], axis=-1) @ w_out
    return out, k, v


def mixer_diff(h, w_in, lq1, lk1, lq2, lk2, sub_g, w_out, pos, ctx_k, ctx_v):
    b_, t = h.shape[0], h.shape[1]
    z = h @ w_in
    idx = [C_QK_WIDTH, 2 * C_QK_WIDTH, 2 * C_QK_WIDTH + C_V_WIDTH]
    q, k, v, g = jnp.split(z, idx, axis=-1)
    q = q.reshape(b_, t, C_HEADS, 2, C_QK_DIM)
    k = k.reshape(b_, t, C_HEADS, 2, C_QK_DIM)
    v = v.reshape(b_, t, C_HEADS, C_V_DIM)
    lam = (jnp.exp(jnp.sum(lq1.astype(F32) * lk1.astype(F32)))
           - jnp.exp(jnp.sum(lq2.astype(F32) * lk2.astype(F32))) + LAMBDA_INIT_1)
    if pos is None:
        qr, k_all, v_all = q, k, v
    else:
        row, col = pos
        qr = rope_2d(q, row, col)
        k_all = jnp.concatenate([rope_2d(k, row, col), ctx_k], axis=1)
        v_all = jnp.concatenate([v, ctx_v], axis=1)
    o = diff_attend(qr, k_all, v_all, lam)
    o = rms_norm(o, sub_g) * (1 - LAMBDA_INIT_1)
    out = (o.reshape(b_, t, C_V_WIDTH) * jax.nn.silu(g)) @ w_out
    return out, k, v


def setup_inputs(seed: int = 0) -> dict:
    key = jax.random.key(seed)
    ks = jax.random.split(key, 32)
    D = D_MODEL

    def nrm(k, shape, s):
        return jax.random.normal(k, shape, F32) * s

    return {
        "x_prompt": nrm(ks[0], (BATCH, SEQ, D), 1.0),
        "x_sample": nrm(ks[1], (DEC_BATCH, DEC_SEQ, D), 1.0),
        "cache_k0": nrm(ks[2], (DEC_BATCH, PAST_LEN, B_KV_HEADS, B_HEAD_DIM), 1.0),
        "cache_v0": nrm(ks[3], (DEC_BATCH, PAST_LEN, B_KV_HEADS, B_HEAD_DIM), 1.0),
        "cache_k1": nrm(ks[4], (DEC_BATCH, PAST_LEN, C_HEADS, 2, C_QK_DIM), 1.0),
        "cache_v1": nrm(ks[5], (DEC_BATCH, PAST_LEN, C_HEADS, C_V_DIM), 1.0),
        "c": nrm(ks[6], (DEC_BATCH, D), 1.0),
        "c_ctx": nrm(ks[7], (D,), 1.0),
        "w_ada0": nrm(ks[8], (D, 3 * D), D ** -0.5),
        "b_ada0": nrm(ks[9], (3 * D,), 0.02),
        "norm_g0": 1.0 + nrm(ks[10], (D,), 0.02),
        "w_in0": nrm(ks[11], (D, IN0_WIDTH), D ** -0.5),
        "w_s0": nrm(ks[12], (A_GROUPS, CHUNK, CHUNK), CHUNK ** -0.5),
        "b_s0": nrm(ks[13], (A_GROUPS, CHUNK), 0.02),
        "q_norm_g0": 1.0 + nrm(ks[14], (B_HEAD_DIM,), 0.02),
        "k_norm_g0": 1.0 + nrm(ks[15], (B_HEAD_DIM,), 0.02),
        "w_out0": nrm(ks[16], (OUT0_WIDTH, D), OUT0_WIDTH ** -0.5),
        "w_ada1": nrm(ks[17], (D, 3 * D), D ** -0.5),
        "b_ada1": nrm(ks[18], (3 * D,), 0.02),
        "norm_g1": 1.0 + nrm(ks[19], (D,), 0.02),
        "w_in1": nrm(ks[20], (D, IN1_WIDTH), D ** -0.5),
        "lambda_q1": nrm(ks[21], (C_QK_DIM,), 0.1),
        "lambda_k1": nrm(ks[22], (C_QK_DIM,), 0.1),
        "lambda_q2": nrm(ks[23], (C_QK_DIM,), 0.1),
        "lambda_k2": nrm(ks[24], (C_QK_DIM,), 0.1),
        "subln_g1": 1.0 + nrm(ks[25], (C_V_DIM,), 0.02),
        "w_out1": nrm(ks[26], (C_V_WIDTH, D), C_V_WIDTH ** -0.5),
        "final_g": 1.0 + nrm(ks[27], (D,), 0.02),
    }


def reference(x_prompt, x_sample, cache_k0, cache_v0, cache_k1, cache_v1, c, c_ctx,
              w_ada0, b_ada0, norm_g0, w_in0, w_s0, b_s0, q_norm_g0, k_norm_g0, w_out0,
              w_ada1, b_ada1, norm_g1, w_in1, lambda_q1, lambda_k1, lambda_q2, lambda_k2,
              subln_g1, w_out1, final_g):
    ada_params = [(w_ada0, b_ada0, norm_g0), (w_ada1, b_ada1, norm_g1)]
    caches = [(cache_k0, cache_v0), (cache_k1, cache_v1)]

    def run_mixer(layer, h, pos, ctx_k, ctx_v):
        if layer % 2 == 0:
            return mixer_ab(h, w_in0, w_s0, b_s0, q_norm_g0, k_norm_g0, w_out0, pos, ctx_k, ctx_v)
        return mixer_diff(h, w_in1, lambda_q1, lambda_k1, lambda_q2, lambda_k2, subln_g1, w_out1,
                          pos, ctx_k, ctx_v)

    x = x_prompt
    ctx_state = []
    for layer in range(DEPTH):
        w_ada, b_ada, ng = ada_params[layer]
        h, gate = ada_modulate(x, c_ctx, w_ada, b_ada, ng)
        out, k_ctx, v_ctx = run_mixer(layer, h, None, None, None)
        x = x + gate * out
        ctx_state.append((k_ctx, v_ctx))
    y_prompt = rms_norm(x, final_g)

    t = x_sample.shape[1]
    rows = t // GRID_W
    row_pos = jnp.repeat(jnp.arange(rows, dtype=F32), GRID_W)
    col_pos = jnp.tile(jnp.arange(GRID_W, dtype=F32), rows)
    pos = (row_pos, col_pos)
    x = x_sample
    for layer in range(DEPTH):
        w_ada, b_ada, ng = ada_params[layer]
        h, gate = ada_modulate(x, c, w_ada, b_ada, ng)
        ck, cv = caches[layer]
        out, _, _ = run_mixer(layer, h, pos, ck, cv)
        x = x + gate * out
    y_sample = rms_norm(x, final_g)

    (new_k0, new_v0), (new_k1, new_v1) = ctx_state
    return (y_prompt, y_sample, new_k0, new_v0, new_k1, new_v1)
```

```cpp
#include <hip/hip_runtime.h>
#include <hip/hip_cooperative_groups.h>
#include <cstdio>
namespace cg = cooperative_groups;

#define LAS __attribute__((address_space(3)))
typedef unsigned short u16;
typedef short bf16x8 __attribute__((ext_vector_type(8)));
typedef short s16x4 __attribute__((ext_vector_type(4)));
typedef float f32x2 __attribute__((ext_vector_type(2)));
typedef float f32x4 __attribute__((ext_vector_type(4)));
typedef float f32x16 __attribute__((ext_vector_type(16)));
typedef unsigned u32x2 __attribute__((ext_vector_type(2)));
typedef unsigned u32x4 __attribute__((ext_vector_type(4)));
typedef __bf16 bf2_t __attribute__((ext_vector_type(2)));

constexpr int NTOK = 16384, NPROMPT = 8192, DM = 2048, IN0 = 5632, IN1 = 8192;
constexpr int LD0 = IN0 + 128, LD1 = IN1 + 128, LDC1 = 2048 + 128;
constexpr int Z0_U = 0, Z0_VA = 1024, Z0_GA = 2048, Z0_Q = 3072, Z0_K = 4096, Z0_V = 4352, Z0_GB = 4608;
constexpr int Z1_Q = 0, Z1_K = 2048, Z1_V = 4096, Z1_G = 6144;
constexpr float EPS = 1e-6f;
constexpr float LAMBDA_INIT = 0.35550906759096926f;
constexpr float LOG2E = 1.4426950408889634f;

constexpr size_t OUT_Y = 0, OUT_K0 = 33554432, OUT_V0 = 35651584, OUT_K1 = 37748736, OUT_V1 = 54525952;
constexpr size_t WS_MOD = 0, WS_ROPE0 = 262144, WS_ROPE1 = 278528, WS_CK0 = 327680, WS_CV0 = 589824, WS_CK1 = 851968, WS_CV1 = 851968 + 2228224;
constexpr size_t WS_WIN1 = 5373952, WS_WOUT1 = WS_WIN1 + 33554432, WS_A = WS_WOUT1 + 8388608, WS_Z = WS_A + 67108864;
constexpr size_t WS_WIN0 = WS_Z + (size_t)NTOK * LD0 * 2, WS_WOUT0 = WS_WIN0 + 23068672, WS_END = WS_Z + (size_t)NTOK * LD1 * 2;
static_assert(WS_CV1 + 2228224 <= WS_WIN1 && WS_END <= 391000000 && WS_WOUT0 + 8388608 <= WS_END, "workspace map");
constexpr int LDS_BYTES = 131072;
constexpr size_t WS_BAR = 229376;

struct Params {
    const float* in[28];
    float* out;
    unsigned char* ws;
    int ph_lo, ph_hi;
};

__device__ __forceinline__ unsigned pk2(float lo, float hi) { f32x2 v = {lo, hi}; bf2_t b = __builtin_convertvector(v, bf2_t); return __builtin_bit_cast(unsigned, b); }
__device__ __forceinline__ float bflo(unsigned w) { return __uint_as_float(w << 16); }
__device__ __forceinline__ float bfhi(unsigned w) { return __uint_as_float(w & 0xffff0000u); }
__device__ __forceinline__ void unpack8(const u32x4 w, float (&f)[8]) {
    f[0] = bflo(w.x); f[1] = bfhi(w.x); f[2] = bflo(w.y); f[3] = bfhi(w.y); f[4] = bflo(w.z); f[5] = bfhi(w.z); f[6] = bflo(w.w); f[7] = bfhi(w.w);
}
__device__ __forceinline__ u32x4 pack8(const float (&f)[8]) { u32x4 w; w.x = pk2(f[0], f[1]); w.y = pk2(f[2], f[3]); w.z = pk2(f[4], f[5]); w.w = pk2(f[6], f[7]); return w; }
__device__ __forceinline__ float wave_sum(float v) {
#pragma unroll
    for (int o = 1; o < 64; o <<= 1) v += __shfl_xor(v, o);
    return v;
}
__device__ __forceinline__ float silu_f(float v) { return v / (1.f + __expf(-v)); }
__device__ __forceinline__ int cond_of_row(int row) { return row < NPROMPT ? 0 : 1 + ((row - NPROMPT) >> 12); }
__device__ __forceinline__ unsigned off_b(unsigned row, unsigned ch) { return 256u * row + 16u * (ch ^ (((row & 3u) << 2) | ((row >> 2) & 3u))); }
#define MFMA32(a, b, c) __builtin_amdgcn_mfma_f32_32x32x16_bf16((a), (b), (c), 0, 0, 0)
__device__ __forceinline__ bf16x8 tr_pair(LAS unsigned char* p0, LAS unsigned char* p1) {
    const s16x4 a = __builtin_amdgcn_ds_read_tr16_b64_v4i16((LAS s16x4*)p0);
    const s16x4 b = __builtin_amdgcn_ds_read_tr16_b64_v4i16((LAS s16x4*)p1);
    return __builtin_shufflevector(a, b, 0, 1, 2, 3, 4, 5, 6, 7);
}

__device__ __forceinline__ void dma16(const void* g, LAS unsigned char* l) {
    asm volatile("s_mov_b32 m0, %0\n\ts_nop 0\n\tglobal_load_lds_dwordx4 %1, off" :: "s"((unsigned)(size_t)l), "v"(g) : "memory", "m0");
}

namespace pg8 {
typedef unsigned short bf16_t;
constexpr int BM = 256, BK = 64, HALF = 128, HTB = HALF * BK * 2, STAGE_BYTES = 8 * HTB, NXCD = 8, WGM = 8;
__device__ __forceinline__ int lds_byte(int r, int c) { const int st = (r >> 4) * 2 + (c >> 5), rr = r & 15, cc = c & 31, ob = rr * 64 + cc * 2; return st * 1024 + (ob ^ (((ob >> 9) & 1) << 5)); }
__device__ __forceinline__ void stage_rc(int b, int& R, int& C) { const int st = b / 1024, sb = b % 1024, swz = sb ^ (((sb >> 9) & 1) << 5); R = (st >> 1) * 16 + swz / 64; C = (st & 1) * 32 + (swz % 64) / 2; }
__device__ __forceinline__ int perm32(int rho) { const int n = rho >> 4, i = rho & 15; return 8 * (i >> 2) + 4 * n + (i & 3); }
struct Unit { int pm, pn; };
struct Gemm { const bf16_t* A; const bf16_t* Bt; int M, N, K; };
struct StaticOrder {
    int nM, nN, nwg, G, c;
    __device__ void init(int M, int N, int G_, int c_) { nM = M / BM; nN = N / BM; nwg = nM * nN; G = G_; c = c_; }
    __device__ bool next(int i, Unit& u) const {
        const long L = (long)i * G + c; if (L >= nwg) return false;
        int wgid = (int)L; { const int q = nwg / NXCD, r = nwg % NXCD, xcd = wgid % NXCD, off = wgid / NXCD; wgid = (xcd < r ? xcd * (q + 1) : r * (q + 1) + (xcd - r) * q) + off; }
        const int nig = WGM * nN, gid = wgid / nig, fm = gid * WGM, gsz = (nM - fm) < WGM ? (nM - fm) : WGM;
        u.pm = fm + ((wgid % nig) % gsz); u.pn = (wgid % nig) / gsz; return true;
    }
};
struct EpiBf16 {
    static constexpr bool PERM = true;
    bf16_t* O; int ldc;
    __device__ __forceinline__ void operator()(const f32x4 (&acc)[2][2][4][2], const Unit& u, int wr, int wc, int fr, int fq) const {
        const int row0 = u.pm * BM + wr * 64 + fr; const int col0 = u.pn * BM + wc * 32 + 8 * fq;
#pragma unroll
        for (int ai = 0; ai < 2; ++ai)
#pragma unroll
            for (int m = 0; m < 4; ++m) { bf16_t* rowp = O + (size_t)(row0 + ai * HALF + m * 16) * ldc + col0;
#pragma unroll
                for (int bj = 0; bj < 2; ++bj) { const f32x4 v0 = acc[ai][bj][m][0], v1 = acc[ai][bj][m][1];
                    u32x4 w; w.x = pk2(v0[0], v0[1]); w.y = pk2(v0[2], v0[3]); w.z = pk2(v1[0], v1[1]); w.w = pk2(v1[2], v1[3]);
                    *(u32x4*)(rowp + bj * HALF) = w; } }
    }
};
struct EpiIn0 {
    static constexpr bool PERM = true;
    bf16_t* O; int ldc; float* outv;
    __device__ __forceinline__ void operator()(const f32x4 (&acc)[2][2][4][2], const Unit& u, int wr, int wc, int fr, int fq) const {
        const int row0 = u.pm * BM + wr * 64 + fr; const int col0 = u.pn * BM + wc * 32 + 8 * fq;
        const bool do_out = u.pm < 32 && u.pn == 17;
#pragma unroll
        for (int ai = 0; ai < 2; ++ai)
#pragma unroll
            for (int m = 0; m < 4; ++m) { const int row = row0 + ai * HALF + m * 16; bf16_t* rowp = O + (size_t)row * ldc + col0;
#pragma unroll
                for (int bj = 0; bj < 2; ++bj) { const f32x4 v0 = acc[ai][bj][m][0], v1 = acc[ai][bj][m][1];
                    u32x4 w; w.x = pk2(v0[0], v0[1]); w.y = pk2(v0[2], v0[3]); w.z = pk2(v1[0], v1[1]); w.w = pk2(v1[2], v1[3]);
                    *(u32x4*)(rowp + bj * HALF) = w;
                    if (do_out) { float* o = outv + (size_t)row * 256 + (col0 - 4352) + bj * HALF; *(f32x4*)o = v0; *(f32x4*)(o + 4) = v1; } } }
    }
};
struct EpiIn1 {
    static constexpr bool PERM = true;
    bf16_t* O; int ldc; float* outk; float* outv; const f32x2* rope;
    __device__ __forceinline__ void operator()(const f32x4 (&acc)[2][2][4][2], const Unit& u, int wr, int wc, int fr, int fq) const {
        const int row0 = u.pm * BM + wr * 64 + fr; const int col0 = u.pn * BM + wc * 32 + 8 * fq;
        const bool sample = u.pm >= 32, do_rope = sample && u.pn < 16, do_out = !sample && u.pn >= 8 && u.pn < 24;
        const bool hi = fq >= 2;
        float* outp = u.pn < 16 ? outk + (col0 - 2048) : outv + (col0 - 4096);
#pragma unroll
        for (int ai = 0; ai < 2; ++ai)
#pragma unroll
            for (int m = 0; m < 4; ++m) { const int row = row0 + ai * HALF + m * 16;
                f32x4 cs[4];
                if (do_rope) { const int t = (row - NPROMPT) & 4095; const int pos = (wc & 1) ? (t & 63) : (t >> 6);
                    const f32x4* rp = (const f32x4*)(rope + pos * 16 + 8 * (fq & 1));
#pragma unroll
                    for (int q = 0; q < 4; ++q) cs[q] = rp[q]; }
                bf16_t* rowp = O + (size_t)row * ldc + col0;
#pragma unroll
                for (int bj = 0; bj < 2; ++bj) { f32x4 v0 = acc[ai][bj][m][0], v1 = acc[ai][bj][m][1];
                    if (u.pn < 8) { v0 *= 0.125f * 1.4426950408889634f; v1 *= 0.125f * 1.4426950408889634f; }
                    if (do_rope) {
#pragma unroll
                        for (int e = 0; e < 8; ++e) { const float x = e < 4 ? v0[e & 3] : v1[e & 3];
                            const auto rr = __builtin_amdgcn_permlane32_swap(__float_as_uint(x), __float_as_uint(x), false, false);
                            const float pf = __uint_as_float(hi ? rr[0] : rr[1]);
                            const float c = cs[e >> 1][(e & 1) * 2], s = cs[e >> 1][(e & 1) * 2 + 1];
                            const float y = hi ? pf * s + x * c : x * c - pf * s;
                            if (e < 4) v0[e & 3] = y; else v1[e & 3] = y; }
                    }
                    u32x4 w; w.x = pk2(v0[0], v0[1]); w.y = pk2(v0[2], v0[3]); w.z = pk2(v1[0], v1[1]); w.w = pk2(v1[2], v1[3]);
                    *(u32x4*)(rowp + bj * HALF) = w;
                    if (do_out) { float* o = outp + (size_t)row * 2048 + bj * HALF; *(f32x4*)o = v0; *(f32x4*)(o + 4) = v1; }
                } }
    }
};
struct EpiResid {
    static constexpr bool PERM = false;
    const float* xa; const float* xb; float* xout; const float* gate;
    __device__ __forceinline__ void operator()(const f32x4 (&acc)[2][2][4][2], const Unit& u, int wr, int wc, int fr, int fq) const {
        const int row0 = u.pm * BM + wr * 64 + fr, col0 = u.pn * BM + wc * 32 + 4 * fq;
        const int ci = u.pm < 32 ? 0 : 1 + ((u.pm - 32) >> 4);
        const float* gp = gate + ci * 6144 + col0;
        f32x4 gv[2][2];
#pragma unroll
        for (int bj = 0; bj < 2; ++bj)
#pragma unroll
            for (int n = 0; n < 2; ++n) gv[bj][n] = *(const f32x4*)(gp + bj * HALF + n * 16);
#pragma unroll
        for (int ai = 0; ai < 2; ++ai)
#pragma unroll
            for (int m = 0; m < 4; ++m) { const int row = row0 + ai * HALF + m * 16;
                const float* xr = (row < NPROMPT ? xa + (size_t)row * DM : xb + (size_t)(row - NPROMPT) * DM) + col0;
                float* orow = xout + (size_t)row * DM + col0;
#pragma unroll
                for (int bj = 0; bj < 2; ++bj)
#pragma unroll
                    for (int n = 0; n < 2; ++n) { const f32x4 xv = *(const f32x4*)(xr + bj * HALF + n * 16);
                        *(f32x4*)(orow + bj * HALF + n * 16) = xv + gv[bj][n] * acc[ai][bj][m][n]; } }
    }
};

template <class Epi, class Sched>
__device__ __forceinline__ void gemm_phase(LAS unsigned char* lds, const Gemm g, const Sched& S, const Epi& E) {
    const int tid = threadIdx.x, wid = __builtin_amdgcn_readfirstlane(tid >> 6), lane = tid & 63, wr = wid >> 2, wc = wid & 3, fr = lane & 15, fq = lane >> 4;
    const int K = g.K, nt = K / BK;
    unsigned voffA[2], voffB[2];
#pragma unroll
    for (int i = 0; i < 2; ++i) { int R, C; stage_rc(tid * 16 + i * 8192, R, C); const int Rb = Epi::PERM ? ((R & ~31) + perm32(R & 31)) : R;
        voffA[i] = (unsigned)(R * K + C) * 2u; voffB[i] = (unsigned)(Rb * K + C) * 2u; }
    const size_t kstep = (size_t)(BK * 2);
    const size_t hstep = (size_t)HALF * K * 2;
    const size_t tstep = 2 * hstep;
    const unsigned ldsw = (unsigned)wid * 1024u;
    const int aoff = lds_byte(wr * 64 + fr, fq * 8), boff = lds_byte(wc * 32 + fr, fq * 8);
#define PG8_SA(b, h) (((b) * 2 + (h)) * HTB)
#define PG8_SB(b, h) ((4 + (b) * 2 + (h)) * HTB)
#define PG8_STAGE(bufoff, gbase, voff) do { _Pragma("unroll") for (int _i = 0; _i < 2; ++_i) \
        __builtin_amdgcn_global_load_lds((const unsigned*)((const char*)(gbase) + (voff)[_i]), (LAS unsigned*)(lds + (bufoff) + ldsw + _i * 8192), 16, 0, 0); } while (0)
#define PG8_LDA(dst, b, h) do { _Pragma("unroll") for (int m = 0; m < 4; ++m) _Pragma("unroll") for (int k = 0; k < 2; ++k) dst[m][k] = *(const LAS bf16x8*)(lds + PG8_SA(b, h) + aoff + m * 2048 + k * 1024); } while (0)
#define PG8_LDB(dst, b, h) do { _Pragma("unroll") for (int n = 0; n < 2; ++n) _Pragma("unroll") for (int k = 0; k < 2; ++k) dst[n][k] = *(const LAS bf16x8*)(lds + PG8_SB(b, h) + boff + n * 2048 + k * 1024); } while (0)
#define PG8_MMA(ai, bj, At, Bt) do { __builtin_amdgcn_s_setprio(1); _Pragma("unroll") for (int m = 0; m < 4; ++m) _Pragma("unroll") for (int n = 0; n < 2; ++n) _Pragma("unroll") for (int k = 0; k < 2; ++k) \
        acc[ai][bj][m][n] = __builtin_amdgcn_mfma_f32_16x16x32_bf16(Bt[n][k], At[m][k], acc[ai][bj][m][n], 0, 0, 0); __builtin_amdgcn_s_setprio(0); } while (0)
#define PG8_WAIT_V(n) asm volatile("s_waitcnt vmcnt(" #n ")" ::: "memory")
#define PG8_WAIT_L(n) asm volatile("s_waitcnt lgkmcnt(" #n ")" ::: "memory")
#define PG8_BAR __builtin_amdgcn_s_barrier()
#define PG8_SCHED __builtin_amdgcn_sched_barrier(0)
    Unit cur, nxt; int ui = 0;
    if (!S.next(0, cur)) return;
    f32x4 acc[2][2][4][2];
#pragma unroll
    for (int a = 0; a < 2; ++a)
#pragma unroll
        for (int b = 0; b < 2; ++b)
#pragma unroll
            for (int m = 0; m < 4; ++m)
#pragma unroll
                for (int n = 0; n < 2; ++n) acc[a][b][m][n] = (f32x4){0.f, 0.f, 0.f, 0.f};
    bf16x8 At[4][2], B0[2][2], B1[2][2];
    const char* cA = (const char*)g.A + (size_t)cur.pm * tstep; const char* cB = (const char*)g.Bt + (size_t)cur.pn * tstep;
    PG8_STAGE(PG8_SB(0, 0), cB, voffB); PG8_STAGE(PG8_SA(0, 0), cA, voffA); PG8_STAGE(PG8_SB(0, 1), cB + hstep, voffB); PG8_STAGE(PG8_SA(0, 1), cA + hstep, voffA);
    if (wr == 1) PG8_BAR;
    PG8_WAIT_V(4); PG8_BAR;
    PG8_STAGE(PG8_SB(1, 0), cB + kstep, voffB); PG8_STAGE(PG8_SA(1, 0), cA + kstep, voffA); PG8_STAGE(PG8_SB(1, 1), cB + hstep + kstep, voffB);
    PG8_WAIT_V(6); PG8_BAR;
    for (;;) {
        const bool has_next = S.next(ui + 1, nxt);
        const char* nA = has_next ? (const char*)g.A + (size_t)nxt.pm * tstep : cA; const char* nB = has_next ? (const char*)g.Bt + (size_t)nxt.pn * tstep : cB;
        for (int t = 0; t < nt; t += 2) {
            const bool last = (t == nt - 2);
            const char* a1 = cA + (size_t)(t + 1) * kstep;
            const char* a2 = last ? nA : cA + (size_t)(t + 2) * kstep; const char* b2 = last ? nB : cB + (size_t)(t + 2) * kstep;
            const char* a3 = a2 + kstep; const char* b3 = b2 + kstep;
            PG8_LDB(B0, 0, 0); PG8_SCHED; PG8_LDA(At, 0, 0); PG8_STAGE(PG8_SA(1, 1), a1 + hstep, voffA);
            PG8_WAIT_L(8); PG8_BAR; PG8_WAIT_L(0); PG8_MMA(0, 0, At, B0); PG8_BAR; PG8_SCHED;
            PG8_LDB(B1, 0, 1); PG8_STAGE(PG8_SB(0, 0), b2, voffB);
            PG8_BAR; PG8_WAIT_L(0); PG8_MMA(0, 1, At, B1); PG8_BAR;
            PG8_LDA(At, 0, 1); PG8_STAGE(PG8_SA(0, 0), a2, voffA);
            PG8_BAR; PG8_WAIT_L(0); PG8_MMA(1, 0, At, B0); PG8_BAR; PG8_SCHED;
            PG8_STAGE(PG8_SB(0, 1), b2 + hstep, voffB);
            PG8_WAIT_V(6); PG8_BAR; PG8_MMA(1, 1, At, B1); PG8_BAR;
            PG8_LDB(B0, 1, 0); PG8_SCHED; PG8_LDA(At, 1, 0); PG8_STAGE(PG8_SA(0, 1), a2 + hstep, voffA);
            PG8_WAIT_L(8); PG8_BAR; PG8_WAIT_L(0); PG8_MMA(0, 0, At, B0); PG8_BAR; PG8_SCHED;
            PG8_LDB(B1, 1, 1); PG8_STAGE(PG8_SB(1, 0), b3, voffB);
            PG8_BAR; PG8_WAIT_L(0); PG8_MMA(0, 1, At, B1); PG8_BAR;
            PG8_LDA(At, 1, 1); PG8_STAGE(PG8_SA(1, 0), a3, voffA);
            PG8_BAR; PG8_WAIT_L(0); PG8_MMA(1, 0, At, B0); PG8_BAR; PG8_SCHED;
            PG8_STAGE(PG8_SB(1, 1), b3 + hstep, voffB);
            PG8_WAIT_V(6); PG8_BAR; PG8_MMA(1, 1, At, B1); PG8_BAR;
        }
        E(acc, cur, wr, wc, fr, fq);
        if (!has_next) break;
#pragma unroll
        for (int a = 0; a < 2; ++a)
#pragma unroll
            for (int b = 0; b < 2; ++b)
#pragma unroll
                for (int m = 0; m < 4; ++m)
#pragma unroll
                    for (int n = 0; n < 2; ++n) acc[a][b][m][n] = (f32x4){0.f, 0.f, 0.f, 0.f};
        cur = nxt; cA = nA; cB = nB; ++ui;
    }
    PG8_WAIT_V(0);
    if (wr == 0) PG8_BAR;
    PG8_BAR;
#undef PG8_SA
#undef PG8_SB
#undef PG8_STAGE
#undef PG8_LDA
#undef PG8_LDB
#undef PG8_MMA
#undef PG8_WAIT_V
#undef PG8_WAIT_L
#undef PG8_BAR
#undef PG8_SCHED
}
}

__device__ __forceinline__ void transpose_item(const float* W, int K, int N, u16* WT, LAS float* scr, int item, int lane) {
    const int nblk = N / 32, kb = item / nblk, nb = item % nblk, k0 = 64 * kb, n0 = 32 * nb;
#pragma unroll 8
    for (int i = 0; i < 32; ++i) { const int kk = 2 * i + (lane >> 5); scr[kk * 33 + (lane & 31)] = W[(size_t)(k0 + kk) * N + n0 + (lane & 31)]; }
    asm volatile("s_waitcnt lgkmcnt(0)" ::: "memory");
    const int c = lane & 7;
#pragma unroll
    for (int j = 0; j < 4; ++j) { const int n = (lane >> 3) + 8 * j; const LAS float* s = scr + (8 * c) * 33 + n;
        u32x4 o; o.x = pk2(s[0 * 33], s[1 * 33]); o.y = pk2(s[2 * 33], s[3 * 33]); o.z = pk2(s[4 * 33], s[5 * 33]); o.w = pk2(s[6 * 33], s[7 * 33]);
        *(u32x4*)(WT + (size_t)(n0 + n) * K + k0 + 8 * c) = o; }
    asm volatile("s_waitcnt lgkmcnt(0)" ::: "memory");
}
__device__ __forceinline__ void cvt_copy(const float* src, u16* dst, int n4, int gtid, int gsz) {
    for (int i = gtid; i < n4; i += gsz) { const f32x4 v = ((const f32x4*)src)[i]; u32x2 w; w.x = pk2(v[0], v[1]); w.y = pk2(v[2], v[3]); ((u32x2*)dst)[i] = w; }
}
__device__ __forceinline__ void phase_prep(const Params& p, LAS unsigned char* lds) {
    const int tid = threadIdx.x, lane = tid & 63, wave = tid >> 6;
    float* mod = (float*)(p.ws + WS_MOD);
    for (int it = blockIdx.x; it < 192; it += gridDim.x) {
        const int l = it / 96, col0 = (it % 96) * 64;
        const float* W = p.in[l ? 17 : 8]; const float* bias = p.in[l ? 18 : 9];
        LAS float* sc = (LAS float*)lds; LAS float* red = sc + 3 * 2048;
        for (int i = tid; i < 3 * 2048; i += 512) { const int ci = i >> 11, k = i & 2047; const float v = ci == 0 ? p.in[7][k] : p.in[6][(ci - 1) * 2048 + k]; sc[i] = v / (1.f + expf(-v)); }
        __syncthreads();
        const int c4 = tid & 15, kq = tid >> 4;
        f32x4 a0 = {0.f, 0.f, 0.f, 0.f}, a1 = a0, a2 = a0;
        const float* wp = W + (size_t)(kq * 64) * 6144 + col0 + c4 * 4;
#pragma unroll 16
        for (int k = 0; k < 64; ++k) { const f32x4 w = *(const f32x4*)(wp + (size_t)k * 6144); const int kk = kq * 64 + k; a0 += w * sc[kk]; a1 += w * sc[2048 + kk]; a2 += w * sc[4096 + kk]; }
        LAS f32x4* red4 = (LAS f32x4*)red;
        red4[(kq * 3 + 0) * 16 + c4] = a0; red4[(kq * 3 + 1) * 16 + c4] = a1; red4[(kq * 3 + 2) * 16 + c4] = a2;
        __syncthreads();
        if (tid < 192) { const int ci = tid >> 6, c = tid & 63; float s = bias[col0 + c];
#pragma unroll 8
            for (int q = 0; q < 32; ++q) s += red[((q * 3 + ci) * 16 + (c >> 2)) * 4 + (c & 3)];
            mod[(l * 3 + ci) * 6144 + col0 + c] = s; }
        __syncthreads();
    }
    {
        LAS float* scr = (LAS float*)(lds + wave * 8448);
        const int gw = blockIdx.x * 8 + wave, NGW = gridDim.x * 8;
        constexpr int I0 = 32 * (IN0 / 32), I1 = 32 * (DM / 32);
        for (int it = gw; it < I0 + I1; it += NGW) {
            if (it < I0) transpose_item(p.in[11], DM, IN0, (u16*)(p.ws + WS_WIN0), scr, it, lane);
            else transpose_item(p.in[16], DM, DM, (u16*)(p.ws + WS_WOUT0), scr, it - I0, lane);
        }
    }
    {
        const int gtid = blockIdx.x * 512 + tid, gsz = gridDim.x * 512;
        cvt_copy(p.in[2], (u16*)(p.ws + WS_CK0), 131072 / 4, gtid, gsz);
        cvt_copy(p.in[3], (u16*)(p.ws + WS_CV0), 131072 / 4, gtid, gsz);
        for (int i = gtid; i < 1048576 / 4; i += gsz) { const int r = i >> 9, c4 = i & 511;
            const f32x4 a = ((const f32x4*)p.in[4])[i], b = ((const f32x4*)p.in[5])[i]; u32x2 wa, wb; wa.x = pk2(a[0], a[1]); wa.y = pk2(a[2], a[3]); wb.x = pk2(b[0], b[1]); wb.y = pk2(b[2], b[3]);
            *(u32x2*)((u16*)(p.ws + WS_CK1) + (size_t)r * LDC1 + c4 * 4) = wa; *(u32x2*)((u16*)(p.ws + WS_CV1) + (size_t)r * LDC1 + c4 * 4) = wb; }
        f32x2* r0 = (f32x2*)(p.ws + WS_ROPE0); f32x2* r1 = (f32x2*)(p.ws + WS_ROPE1);
        for (int i = gtid; i < 64 * 32 + 64 * 16; i += gsz) {
            int pos, idx; float fr;
            if (i < 2048) { pos = i >> 5; idx = i & 31; fr = exp2f(-(float)idx * (13.287712379549449f / 32.f)); }
            else { const int j = i - 2048; pos = j >> 4; idx = j & 15; fr = exp2f(-(float)idx * (13.287712379549449f / 16.f)); }
            float t = (float)pos * fr * 0.15915494309189535f; t -= floorf(t);
            f32x2 cs; cs.x = __builtin_amdgcn_cosf(t); cs.y = __builtin_amdgcn_sinf(t);
            if (i < 2048) r0[i] = cs; else r1[i - 2048] = cs;
        }
    }
}

__device__ __forceinline__ void prep_w1(const Params& p, LAS unsigned char* lds, int part, int nparts) {
    const int tid = threadIdx.x, lane = tid & 63, wave = tid >> 6;
    LAS float* scr = (LAS float*)(lds + wave * 8448);
    constexpr int I2 = 32 * (IN1 / 32), I3 = 32 * (DM / 32);
    for (int it = part * 8 + wave; it < I2 + I3; it += nparts * 8) {
        if (it < I2) transpose_item(p.in[20], DM, IN1, (u16*)(p.ws + WS_WIN1), scr, it, lane);
        else transpose_item(p.in[26], DM, DM, (u16*)(p.ws + WS_WOUT1), scr, it - I2, lane);
    }
}

template <int MODE, bool RES>
__device__ __forceinline__ void phase_norm(const Params& p, int layer, LAS unsigned char* lds) {
    const int tid = threadIdx.x, lane = tid & 63, wave = tid >> 6;
    const int gw = blockIdx.x * 8 + wave, NGW = gridDim.x * 8;
    const float* mod = (const float*)(p.ws + WS_MOD);
    const float* gam = p.in[MODE == 1 ? 27 : (layer ? 19 : 10)];
    u16* hbuf = (u16*)(p.ws + WS_A);
    const u16* outb = (const u16*)(p.ws + WS_Z);
    const int res_layer = MODE == 1 ? 1 : 0;
    const bool x_from_input = (MODE == 0) && (layer == 0 || RES);
    LAS f32x4* Tg = (LAS f32x4*)lds; LAS f32x4* Tm = (LAS f32x4*)(lds + 24576); LAS f32x4* Ts = (LAS f32x4*)(lds + 32768); LAS f32x4* Tb = (LAS f32x4*)(lds + 57344);
    for (int i = tid; i < 3 * 512; i += 512) { const int ci = i >> 9, c = i & 511;
        if (RES) Tg[i] = ((const f32x4*)(mod + (res_layer * 3 + ci) * 6144 + 4096))[c];
        if (MODE == 0) { Tb[i] = ((const f32x4*)(mod + (layer * 3 + ci) * 6144))[c]; Ts[i] = ((const f32x4*)(mod + (layer * 3 + ci) * 6144 + 2048))[c]; } }
    for (int i = tid; i < 512; i += 512) Tm[i] = ((const f32x4*)gam)[i];
    __syncthreads();
    f32x4 xa[8], xb[8]; u32x2 oa[8], ob[8];
#define NORM_LOAD(XV, OV, row_) do { const int r_ = (row_); \
        if (x_from_input) { const float* xr_ = r_ < NPROMPT ? p.in[0] + (size_t)r_ * DM : p.in[1] + (size_t)(r_ - NPROMPT) * DM; \
            _Pragma("unroll") for (int j = 0; j < 8; ++j) XV[j] = ((const f32x4*)xr_)[lane + 64 * j]; } \
        else { const u32x2* xb_ = (const u32x2*)(p.out + OUT_Y + (size_t)r_ * DM); \
            _Pragma("unroll") for (int j = 0; j < 8; ++j) { const u32x2 w_ = xb_[lane + 64 * j]; XV[j] = (f32x4){bflo(w_.x), bfhi(w_.x), bflo(w_.y), bfhi(w_.y)}; } } \
        if (RES) { const u32x2* or_ = (const u32x2*)(outb + (size_t)r_ * DM); _Pragma("unroll") for (int j = 0; j < 8; ++j) OV[j] = or_[lane + 64 * j]; } } while (0)
    int row = gw;
    if (row < NTOK) NORM_LOAD(xa, oa, row);
    while (row < NTOK) {
        const int nrow = row + NGW;
        if (nrow < NTOK) NORM_LOAD(xb, ob, nrow);
        const int ci = cond_of_row(row);
        float ss = 0.f;
#pragma unroll
        for (int j = 0; j < 8; ++j) {
            if (RES) { const f32x4 g = Tg[ci * 512 + lane + 64 * j];
                xa[j][0] += g[0] * bflo(oa[j].x); xa[j][1] += g[1] * bfhi(oa[j].x); xa[j][2] += g[2] * bflo(oa[j].y); xa[j][3] += g[3] * bfhi(oa[j].y); }
            ss += xa[j][0] * xa[j][0] + xa[j][1] * xa[j][1] + xa[j][2] * xa[j][2] + xa[j][3] * xa[j][3]; }
        ss = wave_sum(ss);
        const float rstd = 1.0f / sqrtf(ss * (1.f / DM) + EPS);
        if (MODE == 0) {
            if (RES) { u32x2* xo = (u32x2*)(p.out + OUT_Y + (size_t)row * DM);
#pragma unroll
                for (int j = 0; j < 8; ++j) { u32x2 w; w.x = pk2(xa[j][0], xa[j][1]); w.y = pk2(xa[j][2], xa[j][3]); xo[lane + 64 * j] = w; } }
#pragma unroll
            for (int j = 0; j < 8; ++j) { const int idx = lane + 64 * j; const f32x4 hh = xa[j] * rstd * Tm[idx] * (Ts[ci * 512 + idx] + 1.f) + Tb[ci * 512 + idx];
                u32x2 w; w.x = pk2(hh[0], hh[1]); w.y = pk2(hh[2], hh[3]);
                ((u32x2*)(hbuf + (size_t)row * DM))[idx] = w; }
        } else {
            float* yr = p.out + OUT_Y + (size_t)row * DM;
#pragma unroll
            for (int j = 0; j < 8; ++j) ((f32x4*)yr)[lane + 64 * j] = xa[j] * rstd * Tm[lane + 64 * j];
        }
#pragma unroll
        for (int j = 0; j < 8; ++j) { xa[j] = xb[j]; oa[j] = ob[j]; }
        row = nrow;
    }
#undef NORM_LOAD
}

__device__ __forceinline__ void phase_post0(const Params& p) {
    const int tid = threadIdx.x, lane = tid & 63, wave = tid >> 6;
    const int gw = blockIdx.x * 8 + wave, NGW = gridDim.x * 8;
    u16* z = (u16*)(p.ws + WS_Z);
    const f32x2* rope = (const f32x2*)(p.ws + WS_ROPE0);
    const float* kg = p.in[15];
    const int sub = lane >> 5, cc = lane & 31, head = cc >> 4, c = cc & 15, d0 = c * 8;
    for (int r2 = gw; r2 < NTOK / 2; r2 += NGW) {
        const int row = r2 * 2 + sub;
        u16* zr = z + (size_t)row * LD0 + Z0_K + cc * 8;
        const bool sample = row >= NPROMPT; const int t = (row - NPROMPT) & 4095; const int prow = t >> 6, pcol = t & 63;
        const u32x4 w = *(const u32x4*)zr;
        float f[8]; unpack8(w, f);
        float ss = 0.f;
#pragma unroll
        for (int e = 0; e < 8; ++e) ss += f[e] * f[e];
        ss += __shfl_xor(ss, 1); ss += __shfl_xor(ss, 2); ss += __shfl_xor(ss, 4); ss += __shfl_xor(ss, 8);
        const float rstd = 1.0f / sqrtf(ss * (1.f / 128.f) + EPS);
#pragma unroll
        for (int e = 0; e < 8; ++e) f[e] = f[e] * rstd * kg[d0 + e];
        if (!sample) { float* o = p.out + OUT_K0 + (size_t)row * 256 + head * 128 + d0;
            *(f32x4*)o = (f32x4){f[0], f[1], f[2], f[3]}; *(f32x4*)(o + 4) = (f32x4){f[4], f[5], f[6], f[7]}; }
        if (sample) { const bool first = (c & 4) == 0; const int pos = c < 8 ? prow : pcol; const int i0 = (c & 3) * 8;
#pragma unroll
            for (int e = 0; e < 8; ++e) { const float pf = __shfl_xor(f[e], 4); const f32x2 cs = rope[pos * 32 + i0 + e];
                f[e] = first ? f[e] * cs.x - pf * cs.y : pf * cs.y + f[e] * cs.x; } }
        *(u32x4*)zr = pack8(f);
    }
}
__device__ __forceinline__ void phase_post1(const Params& p) {
    const int tid = threadIdx.x, lane = tid & 63, wave = tid >> 6;
    const int gw = blockIdx.x * 8 + wave, NGW = gridDim.x * 8;
    u16* z = (u16*)(p.ws + WS_Z);
    const f32x2* rope = (const f32x2*)(p.ws + WS_ROPE1);
    for (int row = gw; row < NTOK; row += NGW) {
        u16* zr = z + (size_t)row * LD1;
        if (row < NPROMPT) {
#pragma unroll
            for (int i = 0; i < 8; ++i) { const int cidx = lane + 64 * i;
                const u32x4 w = *(const u32x4*)(zr + Z1_K + cidx * 8); float f[8]; unpack8(w, f);
                float* o = p.out + (cidx < 256 ? OUT_K1 + (size_t)row * 2048 + cidx * 8 : OUT_V1 + (size_t)row * 2048 + (cidx - 256) * 8);
                *(f32x4*)o = (f32x4){f[0], f[1], f[2], f[3]}; *(f32x4*)(o + 4) = (f32x4){f[4], f[5], f[6], f[7]}; }
        } else {
            const int t = (row - NPROMPT) & 4095; const int prow = t >> 6, pcol = t & 63;
#pragma unroll
            for (int i = 0; i < 8; ++i) { const int cidx = lane + 64 * i; const int c = cidx & 7;
                const u32x4 w = *(const u32x4*)(zr + Z1_Q + cidx * 8); float f[8]; unpack8(w, f);
                const bool first = (c & 2) == 0; const int pos = c < 4 ? prow : pcol; const int i0 = (c & 1) * 8;
#pragma unroll
                for (int e = 0; e < 8; ++e) { const float pf = __shfl_xor(f[e], 2); const f32x2 cs = rope[pos * 16 + i0 + e];
                    f[e] = first ? f[e] * cs.x - pf * cs.y : pf * cs.y + f[e] * cs.x; }
                *(u32x4*)(zr + Z1_Q + cidx * 8) = pack8(f); }
        }
    }
}

#define SBAR() do {} while (0)
template <int DQK>
__device__ __forceinline__ void attn_qk32(LAS unsigned char* Kt, const bf16x8 (&qf)[DQK / 16], unsigned kbase, unsigned xr, int kch0, int h, f32x16& s) {
#pragma unroll
    for (int r = 0; r < 16; ++r) s[r] = 0.f;
#pragma unroll
    for (int ks = 0; ks < DQK / 16; ++ks) {
        const unsigned ko = kbase + 16u * (((unsigned)(kch0 + 2 * ks + h)) ^ xr);
        const bf16x8 a = *(const LAS bf16x8*)(Kt + ko);
        s = MFMA32(a, qf[ks], s);
        if (DQK == 128 && ks == 3) SBAR();
    }
}
__device__ __forceinline__ void attn_partial_sm(f32x16& S, float sc, float& m_run, float& alpha, int& resc) {
    float mx = S[0];
#pragma unroll
    for (int r = 1; r < 16; ++r) mx = fmaxf(mx, S[r]);
    { const auto rr = __builtin_amdgcn_permlane32_swap(__float_as_uint(mx), __float_as_uint(mx), false, false);
      mx = fmaxf(__uint_as_float(rr[0]), __uint_as_float(rr[1])); }
    resc = __any((mx - m_run) * sc > 11.5f);
    const float mn = resc ? fmaxf(m_run, mx) : m_run;
    alpha = resc ? __builtin_amdgcn_exp2f((m_run - mn) * sc) : 1.f;
    m_run = mn;
    const float ms = -mn * sc;
#pragma unroll
    for (int r = 0; r < 16; ++r) S[r] = fmaf(S[r], sc, ms);
#pragma unroll
    for (int r = 0; r < 8; ++r) S[r] = __builtin_amdgcn_exp2f(S[r]);
}
__device__ __forceinline__ void attn_finish_sm(f32x16& S, float alpha, float& l_run, bf16x8 (&pb)[2]) {
#pragma unroll
    for (int r = 8; r < 16; ++r) S[r] = __builtin_amdgcn_exp2f(S[r]);
    float rs = 0.f;
#pragma unroll
    for (int r = 0; r < 16; ++r) rs += S[r];
    l_run = l_run * alpha + rs;
#pragma unroll
    for (int s = 0; s < 2; ++s) { u32x4 pw; const int r0 = s * 8;
        pw.x = pk2(S[r0], S[r0 + 1]); pw.y = pk2(S[r0 + 2], S[r0 + 3]); pw.z = pk2(S[r0 + 4], S[r0 + 5]); pw.w = pk2(S[r0 + 6], S[r0 + 7]); pb[s] = __builtin_bit_cast(bf16x8, pw); }
}
__device__ __forceinline__ void attn_pv2(LAS unsigned char* Vt, const unsigned (&vaddr)[2][4], const bf16x8 (&pb)[2], f32x16 (&O)[4]) {
#pragma unroll
    for (int dt = 0; dt < 4; ++dt)
#pragma unroll
        for (int s = 0; s < 2; ++s) {
            const bf16x8 va = tr_pair(Vt + s * 4096 + vaddr[0][dt], Vt + s * 4096 + vaddr[1][dt]);
            O[dt] = MFMA32(va, pb[s], O[dt]);
        }
}
__device__ __forceinline__ void attn_resc(f32x16 (&O)[4], float alpha, int resc) {
    if (resc) {
#pragma unroll
        for (int dt = 0; dt < 4; ++dt) O[dt] *= alpha;
    }
}
__device__ __forceinline__ bf16x8 ones_frag() { u32x4 w; w.x = w.y = w.z = w.w = 0x3F803F80u; return __builtin_bit_cast(bf16x8, w); }
template <int DQK>
__device__ __forceinline__ void attn_qk32_aug(LAS unsigned char* Kt, const bf16x8 (&qf)[DQK / 16], const bf16x8 qaug, unsigned kbase, unsigned xr, int kch0, int h, f32x16& s) {
#pragma unroll
    for (int r = 0; r < 16; ++r) s[r] = 0.f;
    s = MFMA32(ones_frag(), qaug, s);
#pragma unroll
    for (int ks = 0; ks < DQK / 16; ++ks) {
        const unsigned ko = kbase + 16u * (((unsigned)(kch0 + 2 * ks + h)) ^ xr);
        const bf16x8 a = *(const LAS bf16x8*)(Kt + ko);
        s = MFMA32(a, qf[ks], s);
    }
}
__device__ __forceinline__ void attn_partial_sm_aug(f32x16& S, float& m_run, bf16x8& qaug, float& alpha, int& resc, bool force, int h) {
    float mx;
    if (force) {
        mx = S[0];
#pragma unroll
        for (int r = 1; r < 16; ++r) mx = fmaxf(mx, S[r]);
        const auto rr = __builtin_amdgcn_permlane32_swap(__float_as_uint(mx), __float_as_uint(mx), false, false);
        mx = fmaxf(__uint_as_float(rr[0]), __uint_as_float(rr[1]));
        resc = 1;
    } else {
        int mi = __float_as_int(S[0]);
#pragma unroll
        for (int r = 1; r < 16; ++r) mi = max(mi, __float_as_int(S[r]));
        const auto rr = __builtin_amdgcn_permlane32_swap((unsigned)mi, (unsigned)mi, false, false);
        mi = max((int)rr[0], (int)rr[1]);
        mx = __int_as_float(mi);
        resc = __any(mx > 11.5f);
    }
    alpha = 1.f;
    if (__builtin_expect(resc, 0)) {
        asm volatile("" ::: "memory");
        const float d = force ? mx : fmaxf(mx, 0.f);
        const unsigned mb = pk2(m_run + d, 0.f) & 0xffffu;
        const float m_new = __uint_as_float(mb << 16), dd = m_new - m_run;
        alpha = __builtin_amdgcn_exp2f(-dd); m_run = m_new;
#pragma unroll
        for (int r = 0; r < 16; ++r) S[r] -= dd;
        u32x4 qa; qa.x = h == 0 ? (mb ^ 0x8000u) : 0u; qa.y = 0u; qa.z = 0u; qa.w = 0u; qaug = __builtin_bit_cast(bf16x8, qa);
    }
#pragma unroll
    for (int r = 0; r < 8; ++r) S[r] = __builtin_amdgcn_exp2f(S[r]);
}
__device__ __forceinline__ void attn_finish_sm_aug(f32x16& S, bf16x8 (&pb)[2]) {
#pragma unroll
    for (int r = 8; r < 16; ++r) S[r] = __builtin_amdgcn_exp2f(S[r]);
#pragma unroll
    for (int s = 0; s < 2; ++s) { u32x4 pw; const int r0 = s * 8;
        pw.x = pk2(S[r0], S[r0 + 1]); pw.y = pk2(S[r0 + 2], S[r0 + 3]); pw.z = pk2(S[r0 + 4], S[r0 + 5]); pw.w = pk2(S[r0 + 6], S[r0 + 7]); pb[s] = __builtin_bit_cast(bf16x8, pw); }
}
__device__ __forceinline__ void attn_pv2_aug(LAS unsigned char* Vt, const unsigned (&vaddr)[2][4], const bf16x8 (&pb)[2], f32x16 (&O)[4], f32x16& O5) {
    __builtin_amdgcn_s_setprio(1);
#pragma unroll
    for (int dt = 0; dt < 4; ++dt)
#pragma unroll
        for (int s = 0; s < 2; ++s) {
            const bf16x8 va = tr_pair(Vt + s * 4096 + vaddr[0][dt], Vt + s * 4096 + vaddr[1][dt]);
            O[dt] = MFMA32(va, pb[s], O[dt]);
        }
    O5 = MFMA32(ones_frag(), pb[0], O5); O5 = MFMA32(ones_frag(), pb[1], O5);
    __builtin_amdgcn_s_setprio(0);
}
__device__ __forceinline__ void attn_resc_aug(f32x16 (&O)[4], f32x16& O5, float alpha, int resc) {
    if (resc) {
#pragma unroll
        for (int dt = 0; dt < 4; ++dt) O[dt] *= alpha;
        O5 *= alpha;
    }
}
template <int DQK, bool AUG>
__device__ __forceinline__ void attn_core(LAS unsigned char* lds, const bf16x8 (&qf)[DQK / 16],
                                          const u16* kown, const u16* vown, int ldo, int n_own,
                                          const u16* kc, const u16* vc, int ldc, int n_cache, int kch0, float sc,
                                          f32x16 (&O)[4], float& m_run, float& l_run) {
    const int tid = threadIdx.x, lane = tid & 63, wave = __builtin_amdgcn_readfirstlane(tid >> 6), h = lane >> 5, l31 = lane & 31;
    const int ntiles = n_own + n_cache;
    unsigned go_own[2], go_c[2];
#pragma unroll
    for (int i = 0; i < 2; ++i) { const unsigned row = 8u * wave + 4u * i + (lane >> 4); const unsigned ch = (lane & 15u) ^ ((((unsigned)lane >> 4) << 2) | ((2u * wave + i) & 3u));
        go_own[i] = row * (unsigned)ldo + ch * 8u; go_c[i] = row * (unsigned)ldc + ch * 8u; }
    const unsigned ldsw = 2048u * wave;
#define ATT_STAGE(own, cch, t, bufoff) do { const bool o_ = (t) < n_own; \
        const u16* b_ = o_ ? (own) + (size_t)(t) * 64 * ldo : (cch) + (size_t)((t) - n_own) * 64 * ldc; \
        const unsigned g0_ = o_ ? go_own[0] : go_c[0], g1_ = o_ ? go_own[1] : go_c[1]; \
        dma16(b_ + g0_, lds + (bufoff) + ldsw); dma16(b_ + g1_, lds + (bufoff) + ldsw + 1024); } while (0)
#define ATT_SYNC() do { asm volatile("s_waitcnt vmcnt(0)" ::: "memory"); __syncthreads(); } while (0)
    const unsigned xr = ((l31 & 3u) << 2) | ((l31 >> 2) & 3u), kbase = 256u * l31;
    const unsigned blk = (lane >> 4) & 1, q4 = (lane & 15) >> 2, p2 = lane & 3;
    unsigned vaddr[2][4];
#pragma unroll
    for (int t = 0; t < 2; ++t)
#pragma unroll
        for (int dt = 0; dt < 4; ++dt) vaddr[t][dt] = off_b(8 * t + 4 * h + q4, 4 * dt + 2 * blk + (p2 >> 1)) + 8 * (p2 & 1);
    int kcur = 0, knext = 16384, kfree = 32768, vcur = 49152, vnext = 65536;
    ATT_STAGE(kown, kc, 0, kcur); ATT_STAGE(vown, vc, 0, vcur); ATT_STAGE(kown, kc, 1, knext);
    ATT_SYNC();
    f32x16 A, B; bf16x8 pb[2]; float alA, alB; int rsA, rsB;
    f32x16 O5; bf16x8 qaug;
#pragma unroll
    for (int r = 0; r < 16; ++r) O5[r] = 0.f;
    { u32x4 zq; zq.x = zq.y = zq.z = zq.w = 0u; qaug = __builtin_bit_cast(bf16x8, zq); }
#define A_QK(Kp, S_) do { if (AUG) attn_qk32_aug<DQK>(Kp, qf, qaug, kbase, xr, kch0, h, S_); else attn_qk32<DQK>(Kp, qf, kbase, xr, kch0, h, S_); } while (0)
#define A_PART(S_, al_, rs_, force_) do { if (AUG) attn_partial_sm_aug(S_, m_run, qaug, al_, rs_, force_, h); else attn_partial_sm(S_, sc, m_run, al_, rs_); } while (0)
#define A_FIN(S_, al_) do { if (AUG) attn_finish_sm_aug(S_, pb); else attn_finish_sm(S_, al_, l_run, pb); } while (0)
#define A_PV(Vp) do { if (AUG) attn_pv2_aug(Vp, vaddr, pb, O, O5); else attn_pv2(Vp, vaddr, pb, O); } while (0)
#define A_RESC(al_, rs_) do { if (AUG) attn_resc_aug(O, O5, al_, rs_); else attn_resc(O, al_, rs_); } while (0)
    A_QK(lds + kcur, A);
    A_PART(A, alA, rsA, true);
    for (int t = 0; t + 1 < ntiles; ++t) {
        ATT_STAGE(vown, vc, t + 1, vnext);
        if (t + 2 < ntiles) ATT_STAGE(kown, kc, t + 2, kfree);
        SBAR(); A_QK(lds + kcur + 8192, B);
        A_FIN(A, alA); SBAR();
        A_PV(lds + vcur); A_PART(B, alB, rsB, false);
        A_RESC(alB, rsB);
        SBAR(); A_QK(lds + knext, A);
        A_FIN(B, alB); SBAR();
        A_PV(lds + vcur + 8192); A_PART(A, alA, rsA, false);
        ATT_SYNC(); A_RESC(alA, rsA);
        { const int tmp = kcur; kcur = knext; knext = kfree; kfree = tmp; const int tv = vcur; vcur = vnext; vnext = tv; }
    }
    SBAR(); A_QK(lds + kcur + 8192, B);
    A_FIN(A, alA); SBAR();
    A_PV(lds + vcur); A_PART(B, alB, rsB, false);
    A_RESC(alB, rsB);
    A_FIN(B, alB); SBAR();
    A_PV(lds + vcur + 8192);
    if (AUG) l_run = O5[0];
    __syncthreads();
#undef A_QK
#undef A_PART
#undef A_FIN
#undef A_PV
#undef A_RESC
#undef ATT_STAGE
#undef ATT_SYNC
}

__device__ __forceinline__ float silu_fast(float v) { return v * __builtin_amdgcn_rcpf(1.f + __builtin_amdgcn_exp2f(-v * LOG2E)); }
template <int NROWS>
__device__ __forceinline__ void attn_gate_store(LAS unsigned char* ybase, const u16* gate0, int ldg, u16* y0) {
    const int tid = threadIdx.x;
#pragma unroll 2
    for (int i = 0; i < NROWS / 32; ++i) { const int n = tid + 512 * i, row = n >> 4, c = n & 15;
        const u32x4 tw = *(const LAS u32x4*)(ybase + (row >> 5) * 8704 + (row & 31) * 272 + c * 16);
        const u32x4 gw = *(const u32x4*)(gate0 + (size_t)row * ldg + c * 8);
        float t[8], g[8]; unpack8(tw, t); unpack8(gw, g);
#pragma unroll
        for (int e = 0; e < 8; ++e) t[e] *= silu_fast(g[e]);
        *(u32x4*)(y0 + (size_t)row * DM + c * 8) = pack8(t); }
}

__device__ __forceinline__ void gqa_item(const Params& p, LAS unsigned char* lds, int qtok0, int hq, int ktok0, int n_own, int cache_b) {
    const int tid = threadIdx.x, lane = tid & 63, wave = tid >> 6, h = lane >> 5, l31 = lane & 31;
    const u16* z = (const u16*)(p.ws + WS_Z);
    const int kvh = hq >> 2;
    const int qtok = qtok0 + wave * 32 + l31;
    bf16x8 qf[8];
    {
        float qv[8][8]; float ss = 0.f;
#pragma unroll
        for (int ks = 0; ks < 8; ++ks) { const u32x4 w = *(const u32x4*)(z + (size_t)qtok * LD0 + Z0_Q + hq * 128 + ks * 16 + h * 8); unpack8(w, qv[ks]);
#pragma unroll
            for (int j = 0; j < 8; ++j) ss += qv[ks][j] * qv[ks][j]; }
        { const auto rr = __builtin_amdgcn_permlane32_swap(__float_as_uint(ss), __float_as_uint(ss), false, false); ss = __uint_as_float(rr[0]) + __uint_as_float(rr[1]); }
        const float rstd = 1.0f / sqrtf(ss * (1.f / 128.f) + EPS);
        const float* qg = p.in[14];
#pragma unroll
        for (int ks = 0; ks < 8; ++ks) { const f32x4 g0 = *(const f32x4*)(qg + ks * 16 + h * 8), g1 = *(const f32x4*)(qg + ks * 16 + h * 8 + 4);
#pragma unroll
            for (int j = 0; j < 8; ++j) qv[ks][j] *= (rstd * (0.08838834764831845f * LOG2E)) * (j < 4 ? g0[j & 3] : g1[j & 3]); }
        if (cache_b >= 0) { const int t = (qtok - NPROMPT) & 4095; const f32x2* rope = (const f32x2*)(p.ws + WS_ROPE0);
#pragma unroll
            for (int kp = 0; kp < 4; ++kp) { const int k1 = (kp >> 1) * 4 + (kp & 1), k2 = k1 + 2;
                const int pos = kp < 2 ? (t >> 6) : (t & 63); const f32x4* rp = (const f32x4*)(rope + pos * 32 + 16 * (k1 & 1) + 8 * h);
#pragma unroll
                for (int q = 0; q < 4; ++q) { const f32x4 cs = rp[q];
                    { const float a = qv[k1][2 * q], b = qv[k2][2 * q]; qv[k1][2 * q] = a * cs[0] - b * cs[1]; qv[k2][2 * q] = a * cs[1] + b * cs[0]; }
                    { const float a = qv[k1][2 * q + 1], b = qv[k2][2 * q + 1]; qv[k1][2 * q + 1] = a * cs[2] - b * cs[3]; qv[k2][2 * q + 1] = a * cs[3] + b * cs[2]; } } } }
#pragma unroll
        for (int ks = 0; ks < 8; ++ks) qf[ks] = __builtin_bit_cast(bf16x8, pack8(qv[ks]));
    }
    f32x16 O[4];
#pragma unroll
    for (int dt = 0; dt < 4; ++dt)
#pragma unroll
        for (int r = 0; r < 16; ++r) O[dt][r] = 0.f;
    float m_run = 0.f, l_run = 0.f;
    const u16* kc = (const u16*)(p.ws + WS_CK0) + (size_t)(cache_b < 0 ? 0 : cache_b) * 256 * 256 + kvh * 128;
    const u16* vc = (const u16*)(p.ws + WS_CV0) + (size_t)(cache_b < 0 ? 0 : cache_b) * 256 * 256 + kvh * 128;
    attn_core<128, true>(lds, qf, z + (size_t)ktok0 * LD0 + Z0_K + kvh * 128, z + (size_t)ktok0 * LD0 + Z0_V + kvh * 128, LD0, n_own,
                   kc, vc, 256, cache_b < 0 ? 0 : 4, 0, 1.f, O, m_run, l_run);
    const float inv = 1.f / l_run;
    LAS unsigned char* yb = lds + wave * 8704 + l31 * 272;
#pragma unroll
    for (int dt = 0; dt < 4; ++dt)
#pragma unroll
        for (int rg = 0; rg < 4; ++rg) { const int d0 = dt * 32 + rg * 8 + 4 * h;
            u32x2 o; o.x = pk2(O[dt][rg * 4 + 0] * inv, O[dt][rg * 4 + 1] * inv); o.y = pk2(O[dt][rg * 4 + 2] * inv, O[dt][rg * 4 + 3] * inv);
            *(LAS u32x2*)(yb + d0 * 2) = o; }
    __syncthreads();
    attn_gate_store<256>(lds, z + (size_t)qtok0 * LD0 + Z0_GB + hq * 128, LD0, (u16*)(p.ws + WS_A) + (size_t)qtok0 * DM + 1024 + hq * 128);
    __syncthreads();
}

__device__ __forceinline__ void gate_item(const Params& p, LAS unsigned char* lds, int chunk, int gh) {
    const int tid = threadIdx.x, lane = tid & 63, wave = tid >> 6, h = lane >> 5, l31 = lane & 31;
    const u16* z = (const u16*)(p.ws + WS_Z);
    const int tok0 = chunk * 128;
    LAS unsigned char* VN = lds; LAS unsigned char* WSb = lds + 32768; LAS f32x2* ST = (LAS f32x2*)(lds + 65536);
    {
        const int tk = tid >> 2, part = tid & 3; const u16* src = z + (size_t)(tok0 + tk) * LD0 + Z0_VA + part * 256;
        float s = 0.f, s2 = 0.f;
#pragma unroll 8
        for (int i = 0; i < 32; ++i) { const u32x4 w = *(const u32x4*)(src + i * 8); float f[8]; unpack8(w, f);
#pragma unroll
            for (int e = 0; e < 8; ++e) { s += f[e]; s2 += f[e] * f[e]; } }
        s += __shfl_xor(s, 1); s2 += __shfl_xor(s2, 1); s += __shfl_xor(s, 2); s2 += __shfl_xor(s2, 2);
        const float mu = s * (1.f / 1024.f); const float var = fmaxf(s2 * (1.f / 1024.f) - mu * mu, 0.f);
        if (part == 0) { f32x2 st; st.x = mu; st.y = 1.0f / sqrtf(var + EPS); ST[tk] = st; }
    }
    __syncthreads();
    const int ct = wave >> 1, pt0 = (wave & 1) * 2;
    const unsigned blk = (lane >> 4) & 1, q4 = (lane & 15) >> 2, p2 = lane & 3;
    u16* ycat = (u16*)(p.ws + WS_A);
    for (int g = gh * 4; g < gh * 4 + 4; ++g) {
#pragma unroll
        for (int i = 0; i < 4; ++i) { const int n = tid + 512 * i, row = n >> 4, ch = n & 15;
            const u32x4 w = *(const u32x4*)(z + (size_t)(tok0 + row) * LD0 + Z0_VA + g * 128 + ch * 8); const f32x2 st = ST[row];
            float f[8]; unpack8(w, f);
#pragma unroll
            for (int e = 0; e < 8; ++e) f[e] = (f[e] - st.x) * st.y;
            *(LAS u32x4*)(VN + off_b(row, ch)) = pack8(f);
            const float* wsrc = p.in[12] + (size_t)g * 16384 + row * 128 + ch * 8;
            const f32x4 w0 = *(const f32x4*)wsrc, w1 = *(const f32x4*)(wsrc + 4);
            u32x4 o; o.x = pk2(w0[0], w0[1]); o.y = pk2(w0[2], w0[3]); o.z = pk2(w1[0], w1[1]); o.w = pk2(w1[2], w1[3]);
            *(LAS u32x4*)(WSb + off_b(row, ch)) = o; }
        __syncthreads();
        f32x16 acc[2];
#pragma unroll
        for (int r = 0; r < 16; ++r) { acc[0][r] = 0.f; acc[1][r] = 0.f; }
#pragma unroll
        for (int ks = 0; ks < 8; ++ks) {
            const unsigned a0 = off_b(16 * ks + 8 * h + q4, 4 * ct + 2 * blk + (p2 >> 1)) + 8 * (p2 & 1);
            const unsigned a1 = off_b(16 * ks + 8 * h + 4 + q4, 4 * ct + 2 * blk + (p2 >> 1)) + 8 * (p2 & 1);
            const bf16x8 A = tr_pair(VN + a0, VN + a1);
#pragma unroll
            for (int i = 0; i < 2; ++i) { const bf16x8 B = *(const LAS bf16x8*)(WSb + off_b((pt0 + i) * 32 + l31, 2 * ks + h)); acc[i] = MFMA32(A, B, acc[i]); }
        }
        LAS unsigned char* Yb = lds + 69632;
#pragma unroll
        for (int i = 0; i < 2; ++i) { const int pp = (pt0 + i) * 32 + l31; const float bs = p.in[13][g * 128 + pp];
            LAS unsigned char* yb = Yb + (pt0 + i) * 8704 + l31 * 272;
#pragma unroll
            for (int rg = 0; rg < 4; ++rg) { const int c0 = ct * 32 + rg * 8 + 4 * h;
                u32x2 o; o.x = pk2(acc[i][rg * 4 + 0] + bs, acc[i][rg * 4 + 1] + bs); o.y = pk2(acc[i][rg * 4 + 2] + bs, acc[i][rg * 4 + 3] + bs);
                *(LAS u32x2*)(yb + c0 * 2) = o; } }
        __syncthreads();
#pragma unroll
        for (int i = 0; i < 4; ++i) { const int n = tid + 512 * i, row = n >> 4, c = n & 15;
            const u32x4 sw = *(const LAS u32x4*)(Yb + (row >> 5) * 8704 + (row & 31) * 272 + c * 16);
            const u16* zr = z + (size_t)(tok0 + row) * LD0 + g * 128 + c * 8;
            const u32x4 uw = *(const u32x4*)(zr + Z0_U), gw = *(const u32x4*)(zr + Z0_GA);
            float s[8], u[8], ga[8]; unpack8(sw, s); unpack8(uw, u); unpack8(gw, ga);
#pragma unroll
            for (int e = 0; e < 8; ++e) s[e] = u[e] * s[e] * silu_fast(ga[e]);
            *(u32x4*)(ycat + (size_t)(tok0 + row) * DM + g * 128 + c * 8) = pack8(s); }
        __syncthreads();
    }
}

__device__ __forceinline__ void phase_mix0(const Params& p, LAS unsigned char* lds) {
    for (int it = blockIdx.x; it < 512; it += gridDim.x) {
        int qtok0, hq, ktok0, n_own, cb;
        if (it < 256) {
            const int x = it & 7, i = it >> 3, pair = x & 3, b = pair >> 1, kvh = pair & 1, sub = (x >> 2) * 32 + i;
            hq = kvh * 4 + (sub >> 4); qtok0 = NPROMPT + b * 4096 + (sub & 15) * 256; ktok0 = NPROMPT + b * 4096; n_own = 64; cb = b; }
        else { const int r = it - 256, i = r >> 3; hq = r & 7; qtok0 = i * 256; ktok0 = i * 256; n_own = 4; cb = -1; }
        gqa_item(p, lds, qtok0, hq, ktok0, n_own, cb);
    }
    for (int it = blockIdx.x; it < 256; it += gridDim.x) gate_item(p, lds, it >> 1, it & 1);
}

__device__ __forceinline__ void diff_item(const Params& p, LAS unsigned char* lds, int qtok0, int hd, int ktok0, int n_own, int cache_b, float lam) {
    const int tid = threadIdx.x, lane = tid & 63, wave = tid >> 6, h = lane >> 5, l31 = lane & 31;
    const u16* z = (const u16*)(p.ws + WS_Z);
    const int map = wave & 1, qt = wave >> 1;
    const int qtok = qtok0 + qt * 32 + l31;
    bf16x8 qf[4];
#pragma unroll
    for (int ks = 0; ks < 4; ++ks) qf[ks] = *(const bf16x8*)(z + (size_t)qtok * LD1 + Z1_Q + hd * 128 + map * 64 + ks * 16 + h * 8);
    f32x16 O[4];
#pragma unroll
    for (int dt = 0; dt < 4; ++dt)
#pragma unroll
        for (int r = 0; r < 16; ++r) O[dt][r] = 0.f;
    float m_run = 0.f, l_run = 0.f;
    const u16* kc = (const u16*)(p.ws + WS_CK1) + (size_t)(cache_b < 0 ? 0 : cache_b) * 256 * LDC1 + hd * 128;
    const u16* vc = (const u16*)(p.ws + WS_CV1) + (size_t)(cache_b < 0 ? 0 : cache_b) * 256 * LDC1 + hd * 128;
    attn_core<64, true>(lds, qf, z + (size_t)ktok0 * LD1 + Z1_K + hd * 128, z + (size_t)ktok0 * LD1 + Z1_V + hd * 128, LD1, n_own,
                  kc, vc, LDC1, cache_b < 0 ? 0 : 4, map * 8, 1.f, O, m_run, l_run);
    const float inv = 1.f / l_run;
    LAS float* X = (LAS float*)(lds + qt * 16384);
    if (map == 1) {
        const float s = inv * lam;
#pragma unroll
        for (int dt = 0; dt < 4; ++dt)
#pragma unroll
            for (int r = 0; r < 16; ++r) X[(dt * 16 + r) * 64 + lane] = O[dt][r] * s;
    }
    __syncthreads();
    if (map == 0) {
        float ss = 0.f;
#pragma unroll
        for (int dt = 0; dt < 4; ++dt)
#pragma unroll
            for (int r = 0; r < 16; ++r) { const float o = O[dt][r] * inv - X[(dt * 16 + r) * 64 + lane]; O[dt][r] = o; ss += o * o; }
        ss += __shfl_xor(ss, 32);
        const float rstd = (1.f - LAMBDA_INIT) / sqrtf(ss * (1.f / 128.f) + EPS);
        LAS unsigned char* yb = lds + 65536 + qt * 8704 + l31 * 272;
        const float* sg = p.in[25];
#pragma unroll
        for (int dt = 0; dt < 4; ++dt)
#pragma unroll
            for (int rg = 0; rg < 4; ++rg) { const int d0 = dt * 32 + rg * 8 + 4 * h;
                const f32x4 s4 = *(const f32x4*)(sg + d0);
                u32x2 o; o.x = pk2(O[dt][rg * 4 + 0] * rstd * s4[0], O[dt][rg * 4 + 1] * rstd * s4[1]);
                o.y = pk2(O[dt][rg * 4 + 2] * rstd * s4[2], O[dt][rg * 4 + 3] * rstd * s4[3]);
                *(LAS u32x2*)(yb + d0 * 2) = o; }
    }
    __syncthreads();
    attn_gate_store<128>(lds + 65536, z + (size_t)qtok0 * LD1 + Z1_G + hd * 128, LD1, (u16*)(p.ws + WS_A) + (size_t)qtok0 * DM + hd * 128);
    __syncthreads();
}
__device__ __forceinline__ void phase_mix1(const Params& p, LAS unsigned char* lds) {
    const int lane = threadIdx.x & 63;
    const float d1 = wave_sum(p.in[21][lane] * p.in[22][lane]), d2 = wave_sum(p.in[23][lane] * p.in[24][lane]);
    const float lam = expf(d1) - expf(d2) + LAMBDA_INIT;
    for (int it = blockIdx.x; it < 2048; it += gridDim.x) {
        int qtok0, hd, ktok0, n_own, cb;
        if (it < 1024) {
            const int x = it & 7, i = (it >> 3) & 31, r = it >> 8, pair = r * 8 + x, b = pair >> 4;
            hd = pair & 15; qtok0 = NPROMPT + b * 4096 + i * 128; ktok0 = NPROMPT + b * 4096; n_own = 64; cb = b; }
        else { const int r = it - 1024, i = r >> 5; hd = (r >> 1) & 15; qtok0 = i * 256 + (r & 1) * 128; ktok0 = i * 256; n_own = 4; cb = -1; }
        diff_item(p, lds, qtok0, hd, ktok0, n_own, cb, lam);
    }
}

__device__ __forceinline__ void grid_barrier(unsigned* ctr, unsigned target) {
    __syncthreads();
    if (threadIdx.x == 0) {
        __builtin_amdgcn_fence(__ATOMIC_RELEASE, "agent");
        asm volatile("s_waitcnt vmcnt(0) lgkmcnt(0)" ::: "memory");
        __hip_atomic_fetch_add(ctr, 1u, __ATOMIC_RELAXED, __HIP_MEMORY_SCOPE_AGENT);
        while (__hip_atomic_load(ctr, __ATOMIC_RELAXED, __HIP_MEMORY_SCOPE_AGENT) < target) __builtin_amdgcn_s_sleep(2);
        __builtin_amdgcn_fence(__ATOMIC_ACQUIRE, "agent");
        asm volatile("s_waitcnt vmcnt(0) lgkmcnt(0)" ::: "memory");
    }
    __syncthreads();
}

__global__ __launch_bounds__(512, 2) void mega_fwd(Params p) {
    extern __shared__ __attribute__((aligned(16))) unsigned char smem[];
    LAS unsigned char* lds = (LAS unsigned char*)smem;
    cg::grid_group grid = cg::this_grid();
#define PH_ON(n) (p.ph_lo <= (n) && (n) < p.ph_hi)
#define PH_SYNC(n) do { if (p.ph_lo <= (n) && (n) + 1 < p.ph_hi) { bar_target += gridDim.x; grid_barrier(bar_ctr, bar_target); } } while (0)
    unsigned* bar_ctr = (unsigned*)(p.ws + WS_BAR); unsigned bar_target = 0;
    if (p.ph_lo < 0) grid.sync();
#define GEMM_IN(WOFF, NN, LDZ) do { pg8::Gemm g; g.A = (const u16*)(p.ws + WS_A); g.Bt = (const u16*)(p.ws + (WOFF)); g.M = NTOK; g.N = (NN); g.K = DM; \
        pg8::StaticOrder S; S.init(g.M, g.N, gridDim.x, blockIdx.x); pg8::EpiBf16 E; E.O = (u16*)(p.ws + WS_Z); E.ldc = (LDZ); pg8::gemm_phase(lds, g, S, E); } while (0)
#define GEMM_OUT(WOFF, XA, XB, LAYER) do { pg8::Gemm g; g.A = (const u16*)(p.ws + WS_A); g.Bt = (const u16*)(p.ws + (WOFF)); g.M = NTOK; g.N = DM; g.K = DM; \
        pg8::StaticOrder S; S.init(g.M, g.N, gridDim.x, blockIdx.x); pg8::EpiResid E; E.xa = (XA); E.xb = (XB); E.xout = p.out + OUT_Y; \
        E.gate = (const float*)(p.ws + WS_MOD) + (LAYER) * 3 * 6144 + 4096; pg8::gemm_phase(lds, g, S, E); } while (0)
    if (PH_ON(0)) phase_prep(p, lds);
    PH_SYNC(0);
    if (PH_ON(1)) phase_norm<0, false>(p, 0, lds);
    PH_SYNC(1);
    if (PH_ON(2)) { pg8::Gemm g; g.A = (const u16*)(p.ws + WS_A); g.Bt = (const u16*)(p.ws + WS_WIN0); g.M = NTOK; g.N = IN0; g.K = DM;
        pg8::StaticOrder S; S.init(g.M, g.N, gridDim.x, blockIdx.x); pg8::EpiIn0 E; E.O = (u16*)(p.ws + WS_Z); E.ldc = LD0; E.outv = p.out + OUT_V0; pg8::gemm_phase(lds, g, S, E);
        { const int nwg = (NTOK / 256) * (IN0 / 256), G = (int)gridDim.x, rem = nwg % G;
          if (rem == 0) prep_w1(p, lds, blockIdx.x, G); else if ((int)blockIdx.x >= rem) prep_w1(p, lds, blockIdx.x - rem, G - rem); } }
    PH_SYNC(2);
    if (PH_ON(3)) phase_post0(p);
    PH_SYNC(3);
    if (PH_ON(4)) phase_mix0(p, lds);
    PH_SYNC(4);
    if (PH_ON(5)) GEMM_IN(WS_WOUT0, DM, DM);
    PH_SYNC(5);
    if (PH_ON(6)) phase_norm<0, true>(p, 1, lds);
    PH_SYNC(6);
    if (PH_ON(7)) { pg8::Gemm g; g.A = (const u16*)(p.ws + WS_A); g.Bt = (const u16*)(p.ws + WS_WIN1); g.M = NTOK; g.N = IN1; g.K = DM;
        pg8::StaticOrder S; S.init(g.M, g.N, gridDim.x, blockIdx.x); pg8::EpiIn1 E; E.O = (u16*)(p.ws + WS_Z); E.ldc = LD1;
        E.outk = p.out + OUT_K1; E.outv = p.out + OUT_V1; E.rope = (const f32x2*)(p.ws + WS_ROPE1); pg8::gemm_phase(lds, g, S, E); }
    PH_SYNC(7);
    if (PH_ON(9)) phase_mix1(p, lds);
    PH_SYNC(9);
    if (PH_ON(10)) GEMM_IN(WS_WOUT1, DM, DM);
    PH_SYNC(10);
    if (PH_ON(11)) phase_norm<1, true>(p, 1, lds);
}

extern "C" void kernel_launch(void* const* d_in, const int* in_sizes, int n_in, void* d_out, int out_size, void* d_ws, size_t ws_size, hipStream_t stream) {
    static int grid = 0;
    if (grid == 0) {
        if (n_in != 28 || ws_size < WS_END) { fprintf(stderr, "kernel_launch: unexpected n_in %d or ws_size %zu (< %zu)\n", n_in, ws_size, (size_t)WS_END); grid = -1; return; }
        int dev = 0, cus = 0, per_cu = 0;
        hipGetDevice(&dev);
        hipDeviceGetAttribute(&cus, hipDeviceAttributeMultiprocessorCount, dev);
        hipFuncSetAttribute((const void*)mega_fwd, hipFuncAttributeMaxDynamicSharedMemorySize, LDS_BYTES);
        hipOccupancyMaxActiveBlocksPerMultiprocessor(&per_cu, (const void*)mega_fwd, 512, LDS_BYTES);
        if (per_cu < 1) per_cu = 1;
        grid = cus * per_cu;
        if (grid > 256) grid = 256;
    }
    if (grid < 0) return;
    if (hipMemsetAsync((char*)d_ws + WS_BAR, 0, 256, stream) != hipSuccess) { fprintf(stderr, "kernel_launch: memset of the barrier word failed\n"); return; }
    Params p{};
    for (int i = 0; i < 28; ++i) p.in[i] = (const float*)d_in[i];
    p.out = (float*)d_out; p.ws = (unsigned char*)d_ws; p.ph_lo = 0; p.ph_hi = 12;
    void* args[] = {&p};
    hipError_t e = hipLaunchCooperativeKernel((const void*)mega_fwd, dim3(grid), dim3(512), args, LDS_BYTES, stream);
    if (e != hipSuccess) fprintf(stderr, "cooperative launch failed: %s (grid %d)\n", hipGetErrorString(e), grid);
}
```

```cpp
#include <hip/hip_runtime.h>
#include <hip/hip_cooperative_groups.h>
#include <cstdio>
namespace cg = cooperative_groups;

#define LAS __attribute__((address_space(3)))
typedef unsigned short u16;
typedef short bf16x8 __attribute__((ext_vector_type(8)));
typedef short s16x4 __attribute__((ext_vector_type(4)));
typedef float f32x2 __attribute__((ext_vector_type(2)));
typedef float f32x4 __attribute__((ext_vector_type(4)));
typedef float f32x16 __attribute__((ext_vector_type(16)));
typedef unsigned u32x2 __attribute__((ext_vector_type(2)));
typedef unsigned u32x4 __attribute__((ext_vector_type(4)));
typedef __bf16 bf2_t __attribute__((ext_vector_type(2)));

constexpr int NTOK = 16384, NPROMPT = 8192, DM = 2048, IN0 = 5632, IN1 = 8192;
constexpr int LD0 = IN0 + 128, LD1 = IN1 + 128, LDC1 = 2048 + 128;
constexpr int Z0_U = 0, Z0_VA = 1024, Z0_GA = 2048, Z0_Q = 3072, Z0_K = 4096, Z0_V = 4352, Z0_GB = 4608;
constexpr int Z1_Q = 0, Z1_K = 2048, Z1_V = 4096, Z1_G = 6144;
constexpr float EPS = 1e-6f;
constexpr float LAMBDA_INIT = 0.35550906759096926f;
constexpr float LOG2E = 1.4426950408889634f;

constexpr size_t OUT_Y = 0, OUT_K0 = 33554432, OUT_V0 = 35651584, OUT_K1 = 37748736, OUT_V1 = 54525952;
constexpr size_t WS_MOD = 0, WS_ROPE0 = 262144, WS_ROPE1 = 278528, WS_CK0 = 327680, WS_CV0 = 589824, WS_CK1 = 851968, WS_CV1 = 851968 + 2228224;
constexpr size_t WS_WIN1 = 5373952, WS_WOUT1 = WS_WIN1 + 33554432, WS_A = WS_WOUT1 + 8388608, WS_Z = WS_A + 67108864;
constexpr size_t WS_WIN0 = WS_Z + (size_t)NTOK * LD0 * 2, WS_WOUT0 = WS_WIN0 + 23068672, WS_END = WS_Z + (size_t)NTOK * LD1 * 2;
static_assert(WS_CV1 + 2228224 <= WS_WIN1 && WS_END <= 391000000 && WS_WOUT0 + 8388608 <= WS_END, "workspace map");
constexpr int LDS_BYTES = 131072;
constexpr size_t WS_BAR = 229376;

struct Params {
    const float* in[28];
    float* out;
    unsigned char* ws;
    int ph_lo, ph_hi;
};

__device__ __forceinline__ unsigned pk2(float lo, float hi) { f32x2 v = {lo, hi}; bf2_t b = __builtin_convertvector(v, bf2_t); return __builtin_bit_cast(unsigned, b); }
__device__ __forceinline__ float bflo(unsigned w) { return __uint_as_float(w << 16); }
__device__ __forceinline__ float bfhi(unsigned w) { return __uint_as_float(w & 0xffff0000u); }
__device__ __forceinline__ void unpack8(const u32x4 w, float (&f)[8]) {
    f[0] = bflo(w.x); f[1] = bfhi(w.x); f[2] = bflo(w.y); f[3] = bfhi(w.y); f[4] = bflo(w.z); f[5] = bfhi(w.z); f[6] = bflo(w.w); f[7] = bfhi(w.w);
}
__device__ __forceinline__ u32x4 pack8(const float (&f)[8]) { u32x4 w; w.x = pk2(f[0], f[1]); w.y = pk2(f[2], f[3]); w.z = pk2(f[4], f[5]); w.w = pk2(f[6], f[7]); return w; }
__device__ __forceinline__ float wave_sum(float v) {
#pragma unroll
    for (int o = 1; o < 64; o <<= 1) v += __shfl_xor(v, o);
    return v;
}
__device__ __forceinline__ float silu_f(float v) { return v / (1.f + __expf(-v)); }
__device__ __forceinline__ int cond_of_row(int row) { return row < NPROMPT ? 0 : 1 + ((row - NPROMPT) >> 12); }
__device__ __forceinline__ unsigned off_b(unsigned row, unsigned ch) { return 256u * row + 16u * (ch ^ (((row & 3u) << 2) | ((row >> 2) & 3u))); }
#define MFMA32(a, b, c) __builtin_amdgcn_mfma_f32_32x32x16_bf16((a), (b), (c), 0, 0, 0)
__device__ __forceinline__ bf16x8 tr_pair(LAS unsigned char* p0, LAS unsigned char* p1) {
    const s16x4 a = __builtin_amdgcn_ds_read_tr16_b64_v4i16((LAS s16x4*)p0);
    const s16x4 b = __builtin_amdgcn_ds_read_tr16_b64_v4i16((LAS s16x4*)p1);
    return __builtin_shufflevector(a, b, 0, 1, 2, 3, 4, 5, 6, 7);
}

__device__ __forceinline__ void dma16(const void* g, LAS unsigned char* l) {
    asm volatile("s_mov_b32 m0, %0\n\ts_nop 0\n\tglobal_load_lds_dwordx4 %1, off" :: "s"((unsigned)(size_t)l), "v"(g) : "memory", "m0");
}

namespace pg8 {
typedef unsigned short bf16_t;
constexpr int BM = 256, BK = 64, HALF = 128, HTB = HALF * BK * 2, STAGE_BYTES = 8 * HTB, NXCD = 8, WGM = 8;
__device__ __forceinline__ int lds_byte(int r, int c) { const int st = (r >> 4) * 2 + (c >> 5), rr = r & 15, cc = c & 31, ob = rr * 64 + cc * 2; return st * 1024 + (ob ^ (((ob >> 9) & 1) << 5)); }
__device__ __forceinline__ void stage_rc(int b, int& R, int& C) { const int st = b / 1024, sb = b % 1024, swz = sb ^ (((sb >> 9) & 1) << 5); R = (st >> 1) * 16 + swz / 64; C = (st & 1) * 32 + (swz % 64) / 2; }
__device__ __forceinline__ int perm32(int rho) { const int n = rho >> 4, i = rho & 15; return 8 * (i >> 2) + 4 * n + (i & 3); }
struct Unit { int pm, pn; };
struct Gemm { const bf16_t* A; const bf16_t* Bt; int M, N, K; };
struct StaticOrder {
    int nM, nN, nwg, G, c;
    __device__ void init(int M, int N, int G_, int c_) { nM = M / BM; nN = N / BM; nwg = nM * nN; G = G_; c = c_; }
    __device__ bool next(int i, Unit& u) const {
        const long L = (long)i * G + c; if (L >= nwg) return false;
        int wgid = (int)L; { const int q = nwg / NXCD, r = nwg % NXCD, xcd = wgid % NXCD, off = wgid / NXCD; wgid = (xcd < r ? xcd * (q + 1) : r * (q + 1) + (xcd - r) * q) + off; }
        const int nig = WGM * nN, gid = wgid / nig, fm = gid * WGM, gsz = (nM - fm) < WGM ? (nM - fm) : WGM;
        u.pm = fm + ((wgid % nig) % gsz); u.pn = (wgid % nig) / gsz; return true;
    }
};
struct EpiBf16 {
    static constexpr bool PERM = true;
    bf16_t* O; int ldc;
    __device__ __forceinline__ void operator()(const f32x4 (&acc)[2][2][4][2], const Unit& u, int wr, int wc, int fr, int fq) const {
        const int row0 = u.pm * BM + wr * 64 + fr; const int col0 = u.pn * BM + wc * 32 + 8 * fq;
#pragma unroll
        for (int ai = 0; ai < 2; ++ai)
#pragma unroll
            for (int m = 0; m < 4; ++m) { bf16_t* rowp = O + (size_t)(row0 + ai * HALF + m * 16) * ldc + col0;
#pragma unroll
                for (int bj = 0; bj < 2; ++bj) { const f32x4 v0 = acc[ai][bj][m][0], v1 = acc[ai][bj][m][1];
                    u32x4 w; w.x = pk2(v0[0], v0[1]); w.y = pk2(v0[2], v0[3]); w.z = pk2(v1[0], v1[1]); w.w = pk2(v1[2], v1[3]);
                    *(u32x4*)(rowp + bj * HALF) = w; } }
    }
};
struct EpiIn0 {
    static constexpr bool PERM = true;
    bf16_t* O; int ldc; float* outv;
    __device__ __forceinline__ void operator()(const f32x4 (&acc)[2][2][4][2], const Unit& u, int wr, int wc, int fr, int fq) const {
        const int row0 = u.pm * BM + wr * 64 + fr; const int col0 = u.pn * BM + wc * 32 + 8 * fq;
        const bool do_out = u.pm < 32 && u.pn == 17;
#pragma unroll
        for (int ai = 0; ai < 2; ++ai)
#pragma unroll
            for (int m = 0; m < 4; ++m) { const int row = row0 + ai * HALF + m * 16; bf16_t* rowp = O + (size_t)row * ldc + col0;
#pragma unroll
                for (int bj = 0; bj < 2; ++bj) { const f32x4 v0 = acc[ai][bj][m][0], v1 = acc[ai][bj][m][1];
                    u32x4 w; w.x = pk2(v0[0], v0[1]); w.y = pk2(v0[2], v0[3]); w.z = pk2(v1[0], v1[1]); w.w = pk2(v1[2], v1[3]);
                    *(u32x4*)(rowp + bj * HALF) = w;
                    if (do_out) { float* o = outv + (size_t)row * 256 + (col0 - 4352) + bj * HALF; *(f32x4*)o = v0; *(f32x4*)(o + 4) = v1; } } }
    }
};
struct EpiIn1 {
    static constexpr bool PERM = true;
    bf16_t* O; int ldc; float* outk; float* outv; const f32x2* rope;
    __device__ __forceinline__ void operator()(const f32x4 (&acc)[2][2][4][2], const Unit& u, int wr, int wc, int fr, int fq) const {
        const int row0 = u.pm * BM + wr * 64 + fr; const int col0 = u.pn * BM + wc * 32 + 8 * fq;
        const bool sample = u.pm >= 32, do_rope = sample && u.pn < 16, do_out = !sample && u.pn >= 8 && u.pn < 24;
        const bool hi = fq >= 2;
        float* outp = u.pn < 16 ? outk + (col0 - 2048) : outv + (col0 - 4096);
#pragma unroll
        for (int ai = 0; ai < 2; ++ai)
#pragma unroll
            for (int m = 0; m < 4; ++m) { const int row = row0 + ai * HALF + m * 16;
                f32x4 cs[4];
                if (do_rope) { const int t = (row - NPROMPT) & 4095; const int pos = (wc & 1) ? (t & 63) : (t >> 6);
                    const f32x4* rp = (const f32x4*)(rope + pos * 16 + 8 * (fq & 1));
#pragma unroll
                    for (int q = 0; q < 4; ++q) cs[q] = rp[q]; }
                bf16_t* rowp = O + (size_t)row * ldc + col0;
#pragma unroll
                for (int bj = 0; bj < 2; ++bj) { f32x4 v0 = acc[ai][bj][m][0], v1 = acc[ai][bj][m][1];
                    if (u.pn < 8) { v0 *= 0.125f * 1.4426950408889634f; v1 *= 0.125f * 1.4426950408889634f; }
                    if (do_rope) {
#pragma unroll
                        for (int e = 0; e < 8; ++e) { const float x = e < 4 ? v0[e & 3] : v1[e & 3];
                            const auto rr = __builtin_amdgcn_permlane32_swap(__float_as_uint(x), __float_as_uint(x), false, false);
                            const float pf = __uint_as_float(hi ? rr[0] : rr[1]);
                            const float c = cs[e >> 1][(e & 1) * 2], s = cs[e >> 1][(e & 1) * 2 + 1];
                            const float y = hi ? pf * s + x * c : x * c - pf * s;
                            if (e < 4) v0[e & 3] = y; else v1[e & 3] = y; }
                    }
                    u32x4 w; w.x = pk2(v0[0], v0[1]); w.y = pk2(v0[2], v0[3]); w.z = pk2(v1[0], v1[1]); w.w = pk2(v1[2], v1[3]);
                    *(u32x4*)(rowp + bj * HALF) = w;
                    if (do_out) { float* o = outp + (size_t)row * 2048 + bj * HALF; *(f32x4*)o = v0; *(f32x4*)(o + 4) = v1; }
                } }
    }
};
struct EpiResid {
    static constexpr bool PERM = false;
    const float* xa; const float* xb; float* xout; const float* gate;
    __device__ __forceinline__ void operator()(const f32x4 (&acc)[2][2][4][2], const Unit& u, int wr, int wc, int fr, int fq) const {
        const int row0 = u.pm * BM + wr * 64 + fr, col0 = u.pn * BM + wc * 32 + 4 * fq;
        const int ci = u.pm < 32 ? 0 : 1 + ((u.pm - 32) >> 4);
        const float* gp = gate + ci * 6144 + col0;
        f32x4 gv[2][2];
#pragma unroll
        for (int bj = 0; bj < 2; ++bj)
#pragma unroll
            for (int n = 0; n < 2; ++n) gv[bj][n] = *(const f32x4*)(gp + bj * HALF + n * 16);
#pragma unroll
        for (int ai = 0; ai < 2; ++ai)
#pragma unroll
            for (int m = 0; m < 4; ++m) { const int row = row0 + ai * HALF + m * 16;
                const float* xr = (row < NPROMPT ? xa + (size_t)row * DM : xb + (size_t)(row - NPROMPT) * DM) + col0;
                float* orow = xout + (size_t)row * DM + col0;
#pragma unroll
                for (int bj = 0; bj < 2; ++bj)
#pragma unroll
                    for (int n = 0; n < 2; ++n) { const f32x4 xv = *(const f32x4*)(xr + bj * HALF + n * 16);
                        *(f32x4*)(orow + bj * HALF + n * 16) = xv + gv[bj][n] * acc[ai][bj][m][n]; } }
    }
};

template <class Epi, class Sched>
__device__ __forceinline__ void gemm_phase(LAS unsigned char* lds, const Gemm g, const Sched& S, const Epi& E) {
    const int tid = threadIdx.x, wid = __builtin_amdgcn_readfirstlane(tid >> 6), lane = tid & 63, wr = wid >> 2, wc = wid & 3, fr = lane & 15, fq = lane >> 4;
    const int K = g.K, nt = K / BK;
    unsigned voffA[2], voffB[2];
#pragma unroll
    for (int i = 0; i < 2; ++i) { int R, C; stage_rc(tid * 16 + i * 8192, R, C); const int Rb = Epi::PERM ? ((R & ~31) + perm32(R & 31)) : R;
        voffA[i] = (unsigned)(R * K + C) * 2u; voffB[i] = (unsigned)(Rb * K + C) * 2u; }
    const size_t kstep = (size_t)(BK * 2);
    const size_t hstep = (size_t)HALF * K * 2;
    const size_t tstep = 2 * hstep;
    const unsigned ldsw = (unsigned)wid * 1024u;
    const int aoff = lds_byte(wr * 64 + fr, fq * 8), boff = lds_byte(wc * 32 + fr, fq * 8);
#define PG8_SA(b, h) (((b) * 2 + (h)) * HTB)
#define PG8_SB(b, h) ((4 + (b) * 2 + (h)) * HTB)
#define PG8_STAGE(bufoff, gbase, voff) do { _Pragma("unroll") for (int _i = 0; _i < 2; ++_i) \
        __builtin_amdgcn_global_load_lds((const unsigned*)((const char*)(gbase) + (voff)[_i]), (LAS unsigned*)(lds + (bufoff) + ldsw + _i * 8192), 16, 0, 0); } while (0)
#define PG8_LDA(dst, b, h) do { _Pragma("unroll") for (int m = 0; m < 4; ++m) _Pragma("unroll") for (int k = 0; k < 2; ++k) dst[m][k] = *(const LAS bf16x8*)(lds + PG8_SA(b, h) + aoff + m * 2048 + k * 1024); } while (0)
#define PG8_LDB(dst, b, h) do { _Pragma("unroll") for (int n = 0; n < 2; ++n) _Pragma("unroll") for (int k = 0; k < 2; ++k) dst[n][k] = *(const LAS bf16x8*)(lds + PG8_SB(b, h) + boff + n * 2048 + k * 1024); } while (0)
#define PG8_MMA(ai, bj, At, Bt) do { __builtin_amdgcn_s_setprio(1); _Pragma("unroll") for (int m = 0; m < 4; ++m) _Pragma("unroll") for (int n = 0; n < 2; ++n) _Pragma("unroll") for (int k = 0; k < 2; ++k) \
        acc[ai][bj][m][n] = __builtin_amdgcn_mfma_f32_16x16x32_bf16(Bt[n][k], At[m][k], acc[ai][bj][m][n], 0, 0, 0); __builtin_amdgcn_s_setprio(0); } while (0)
#define PG8_WAIT_V(n) asm volatile("s_waitcnt vmcnt(" #n ")" ::: "memory")
#define PG8_WAIT_L(n) asm volatile("s_waitcnt lgkmcnt(" #n ")" ::: "memory")
#define PG8_BAR __builtin_amdgcn_s_barrier()
#define PG8_SCHED __builtin_amdgcn_sched_barrier(0)
    Unit cur, nxt; int ui = 0;
    if (!S.next(0, cur)) return;
    f32x4 acc[2][2][4][2];
#pragma unroll
    for (int a = 0; a < 2; ++a)
#pragma unroll
        for (int b = 0; b < 2; ++b)
#pragma unroll
            for (int m = 0; m < 4; ++m)
#pragma unroll
                for (int n = 0; n < 2; ++n) acc[a][b][m][n] = (f32x4){0.f, 0.f, 0.f, 0.f};
    bf16x8 At[4][2], B0[2][2], B1[2][2];
    const char* cA = (const char*)g.A + (size_t)cur.pm * tstep; const char* cB = (const char*)g.Bt + (size_t)cur.pn * tstep;
    PG8_STAGE(PG8_SB(0, 0), cB, voffB); PG8_STAGE(PG8_SA(0, 0), cA, voffA); PG8_STAGE(PG8_SB(0, 1), cB + hstep, voffB); PG8_STAGE(PG8_SA(0, 1), cA + hstep, voffA);
    if (wr == 1) PG8_BAR;
    PG8_WAIT_V(4); PG8_BAR;
    PG8_STAGE(PG8_SB(1, 0), cB + kstep, voffB); PG8_STAGE(PG8_SA(1, 0), cA + kstep, voffA); PG8_STAGE(PG8_SB(1, 1), cB + hstep + kstep, voffB);
    PG8_WAIT_V(6); PG8_BAR;
    for (;;) {
        const bool has_next = S.next(ui + 1, nxt);
        const char* nA = has_next ? (const char*)g.A + (size_t)nxt.pm * tstep : cA; const char* nB = has_next ? (const char*)g.Bt + (size_t)nxt.pn * tstep : cB;
        for (int t = 0; t < nt; t += 2) {
            const bool last = (t == nt - 2);
            const char* a1 = cA + (size_t)(t + 1) * kstep;
            const char* a2 = last ? nA : cA + (size_t)(t + 2) * kstep; const char* b2 = last ? nB : cB + (size_t)(t + 2) * kstep;
            const char* a3 = a2 + kstep; const char* b3 = b2 + kstep;
            PG8_LDB(B0, 0, 0); PG8_SCHED; PG8_LDA(At, 0, 0); PG8_STAGE(PG8_SA(1, 1), a1 + hstep, voffA);
            PG8_WAIT_L(8); PG8_BAR; PG8_WAIT_L(0); PG8_MMA(0, 0, At, B0); PG8_BAR; PG8_SCHED;
            PG8_LDB(B1, 0, 1); PG8_STAGE(PG8_SB(0, 0), b2, voffB);
            PG8_BAR; PG8_WAIT_L(0); PG8_MMA(0, 1, At, B1); PG8_BAR;
            PG8_LDA(At, 0, 1); PG8_STAGE(PG8_SA(0, 0), a2, voffA);
            PG8_BAR; PG8_WAIT_L(0); PG8_MMA(1, 0, At, B0); PG8_BAR; PG8_SCHED;
            PG8_STAGE(PG8_SB(0, 1), b2 + hstep, voffB);
            PG8_WAIT_V(6); PG8_BAR; PG8_MMA(1, 1, At, B1); PG8_BAR;
            PG8_LDB(B0, 1, 0); PG8_SCHED; PG8_LDA(At, 1, 0); PG8_STAGE(PG8_SA(0, 1), a2 + hstep, voffA);
            PG8_WAIT_L(8); PG8_BAR; PG8_WAIT_L(0); PG8_MMA(0, 0, At, B0); PG8_BAR; PG8_SCHED;
            PG8_LDB(B1, 1, 1); PG8_STAGE(PG8_SB(1, 0), b3, voffB);
            PG8_BAR; PG8_WAIT_L(0); PG8_MMA(0, 1, At, B1); PG8_BAR;
            PG8_LDA(At, 1, 1); PG8_STAGE(PG8_SA(1, 0), a3, voffA);
            PG8_BAR; PG8_WAIT_L(0); PG8_MMA(1, 0, At, B0); PG8_BAR; PG8_SCHED;
            PG8_STAGE(PG8_SB(1, 1), b3 + hstep, voffB);
            PG8_WAIT_V(6); PG8_BAR; PG8_MMA(1, 1, At, B1); PG8_BAR;
        }
        E(acc, cur, wr, wc, fr, fq);
        if (!has_next) break;
#pragma unroll
        for (int a = 0; a < 2; ++a)
#pragma unroll
            for (int b = 0; b < 2; ++b)
#pragma unroll
                for (int m = 0; m < 4; ++m)
#pragma unroll
                    for (int n = 0; n < 2; ++n) acc[a][b][m][n] = (f32x4){0.f, 0.f, 0.f, 0.f};
        cur = nxt; cA = nA; cB = nB; ++ui;
    }
    PG8_WAIT_V(0);
    if (wr == 0) PG8_BAR;
    PG8_BAR;
#undef PG8_SA
#undef PG8_SB
#undef PG8_STAGE
#undef PG8_LDA
#undef PG8_LDB
#undef PG8_MMA
#undef PG8_WAIT_V
#undef PG8_WAIT_L
#undef PG8_BAR
#undef PG8_SCHED
}
}

__device__ __forceinline__ void transpose_item(const float* W, int K, int N, u16* WT, LAS float* scr, int item, int lane) {
    const int nblk = N / 32, kb = item / nblk, nb = item % nblk, k0 = 64 * kb, n0 = 32 * nb;
#pragma unroll 8
    for (int i = 0; i < 32; ++i) { const int kk = 2 * i + (lane >> 5); scr[kk * 33 + (lane & 31)] = W[(size_t)(k0 + kk) * N + n0 + (lane & 31)]; }
    asm volatile("s_waitcnt lgkmcnt(0)" ::: "memory");
    const int c = lane & 7;
#pragma unroll
    for (int j = 0; j < 4; ++j) { const int n = (lane >> 3) + 8 * j; const LAS float* s = scr + (8 * c) * 33 + n;
        u32x4 o; o.x = pk2(s[0 * 33], s[1 * 33]); o.y = pk2(s[2 * 33], s[3 * 33]); o.z = pk2(s[4 * 33], s[5 * 33]); o.w = pk2(s[6 * 33], s[7 * 33]);
        *(u32x4*)(WT + (size_t)(n0 + n) * K + k0 + 8 * c) = o; }
    asm volatile("s_waitcnt lgkmcnt(0)" ::: "memory");
}
__device__ __forceinline__ void cvt_copy(const float* src, u16* dst, int n4, int gtid, int gsz) {
    for (int i = gtid; i < n4; i += gsz) { const f32x4 v = ((const f32x4*)src)[i]; u32x2 w; w.x = pk2(v[0], v[1]); w.y = pk2(v[2], v[3]); ((u32x2*)dst)[i] = w; }
}
__device__ __forceinline__ void phase_prep(const Params& p, LAS unsigned char* lds) {
    const int tid = threadIdx.x, lane = tid & 63, wave = tid >> 6;
    float* mod = (float*)(p.ws + WS_MOD);
    for (int it = blockIdx.x; it < 192; it += gridDim.x) {
        const int l = it / 96, col0 = (it % 96) * 64;
        const float* W = p.in[l ? 17 : 8]; const float* bias = p.in[l ? 18 : 9];
        LAS float* sc = (LAS float*)lds; LAS float* red = sc + 3 * 2048;
        for (int i = tid; i < 3 * 2048; i += 512) { const int ci = i >> 11, k = i & 2047; const float v = ci == 0 ? p.in[7][k] : p.in[6][(ci - 1) * 2048 + k]; sc[i] = v / (1.f + expf(-v)); }
        __syncthreads();
        const int c4 = tid & 15, kq = tid >> 4;
        f32x4 a0 = {0.f, 0.f, 0.f, 0.f}, a1 = a0, a2 = a0;
        const float* wp = W + (size_t)(kq * 64) * 6144 + col0 + c4 * 4;
#pragma unroll 16
        for (int k = 0; k < 64; ++k) { const f32x4 w = *(const f32x4*)(wp + (size_t)k * 6144); const int kk = kq * 64 + k; a0 += w * sc[kk]; a1 += w * sc[2048 + kk]; a2 += w * sc[4096 + kk]; }
        LAS f32x4* red4 = (LAS f32x4*)red;
        red4[(kq * 3 + 0) * 16 + c4] = a0; red4[(kq * 3 + 1) * 16 + c4] = a1; red4[(kq * 3 + 2) * 16 + c4] = a2;
        __syncthreads();
        if (tid < 192) { const int ci = tid >> 6, c = tid & 63; float s = bias[col0 + c];
#pragma unroll 8
            for (int q = 0; q < 32; ++q) s += red[((q * 3 + ci) * 16 + (c >> 2)) * 4 + (c & 3)];
            mod[(l * 3 + ci) * 6144 + col0 + c] = s; }
        __syncthreads();
    }
    {
        LAS float* scr = (LAS float*)(lds + wave * 8448);
        const int gw = blockIdx.x * 8 + wave, NGW = gridDim.x * 8;
        constexpr int I0 = 32 * (IN0 / 32), I1 = 32 * (DM / 32);
        for (int it = gw; it < I0 + I1; it += NGW) {
            if (it < I0) transpose_item(p.in[11], DM, IN0, (u16*)(p.ws + WS_WIN0), scr, it, lane);
            else transpose_item(p.in[16], DM, DM, (u16*)(p.ws + WS_WOUT0), scr, it - I0, lane);
        }
    }
    {
        const int gtid = blockIdx.x * 512 + tid, gsz = gridDim.x * 512;
        cvt_copy(p.in[2], (u16*)(p.ws + WS_CK0), 131072 / 4, gtid, gsz);
        cvt_copy(p.in[3], (u16*)(p.ws + WS_CV0), 131072 / 4, gtid, gsz);
        for (int i = gtid; i < 1048576 / 4; i += gsz) { const int r = i >> 9, c4 = i & 511;
            const f32x4 a = ((const f32x4*)p.in[4])[i], b = ((const f32x4*)p.in[5])[i]; u32x2 wa, wb; wa.x = pk2(a[0], a[1]); wa.y = pk2(a[2], a[3]); wb.x = pk2(b[0], b[1]); wb.y = pk2(b[2], b[3]);
            *(u32x2*)((u16*)(p.ws + WS_CK1) + (size_t)r * LDC1 + c4 * 4) = wa; *(u32x2*)((u16*)(p.ws + WS_CV1) + (size_t)r * LDC1 + c4 * 4) = wb; }
        f32x2* r0 = (f32x2*)(p.ws + WS_ROPE0); f32x2* r1 = (f32x2*)(p.ws + WS_ROPE1);
        for (int i = gtid; i < 64 * 32 + 64 * 16; i += gsz) {
            int pos, idx; float fr;
            if (i < 2048) { pos = i >> 5; idx = i & 31; fr = exp2f(-(float)idx * (13.287712379549449f / 32.f)); }
            else { const int j = i - 2048; pos = j >> 4; idx = j & 15; fr = exp2f(-(float)idx * (13.287712379549449f / 16.f)); }
            float t = (float)pos * fr * 0.15915494309189535f; t -= floorf(t);
            f32x2 cs; cs.x = __builtin_amdgcn_cosf(t); cs.y = __builtin_amdgcn_sinf(t);
            if (i < 2048) r0[i] = cs; else r1[i - 2048] = cs;
        }
    }
}

__device__ __forceinline__ void prep_w1(const Params& p, LAS unsigned char* lds, int part, int nparts) {
    const int tid = threadIdx.x, lane = tid & 63, wave = tid >> 6;
    LAS float* scr = (LAS float*)(lds + wave * 8448);
    constexpr int I2 = 32 * (IN1 / 32), I3 = 32 * (DM / 32);
    for (int it = part * 8 + wave; it < I2 + I3; it += nparts * 8) {
        if (it < I2) transpose_item(p.in[20], DM, IN1, (u16*)(p.ws + WS_WIN1), scr, it, lane);
        else transpose_item(p.in[26], DM, DM, (u16*)(p.ws + WS_WOUT1), scr, it - I2, lane);
    }
}

template <int MODE, bool RES>
__device__ __forceinline__ void phase_norm(const Params& p, int layer, LAS unsigned char* lds) {
    const int tid = threadIdx.x, lane = tid & 63, wave = tid >> 6;
    const int gw = blockIdx.x * 8 + wave, NGW = gridDim.x * 8;
    const float* mod = (const float*)(p.ws + WS_MOD);
    const float* gam = p.in[MODE == 1 ? 27 : (layer ? 19 : 10)];
    u16* hbuf = (u16*)(p.ws + WS_A);
    const u16* outb = (const u16*)(p.ws + WS_Z);
    const int res_layer = MODE == 1 ? 1 : 0;
    const bool x_from_input = (MODE == 0) && (layer == 0 || RES);
    LAS f32x4* Tg = (LAS f32x4*)lds; LAS f32x4* Tm = (LAS f32x4*)(lds + 24576); LAS f32x4* Ts = (LAS f32x4*)(lds + 32768); LAS f32x4* Tb = (LAS f32x4*)(lds + 57344);
    for (int i = tid; i < 3 * 512; i += 512) { const int ci = i >> 9, c = i & 511;
        if (RES) Tg[i] = ((const f32x4*)(mod + (res_layer * 3 + ci) * 6144 + 4096))[c];
        if (MODE == 0) { Tb[i] = ((const f32x4*)(mod + (layer * 3 + ci) * 6144))[c]; Ts[i] = ((const f32x4*)(mod + (layer * 3 + ci) * 6144 + 2048))[c]; } }
    for (int i = tid; i < 512; i += 512) Tm[i] = ((const f32x4*)gam)[i];
    __syncthreads();
    f32x4 xa[8], xb[8]; u32x2 oa[8], ob[8];
#define NORM_LOAD(XV, OV, row_) do { const int r_ = (row_); \
        if (x_from_input) { const float* xr_ = r_ < NPROMPT ? p.in[0] + (size_t)r_ * DM : p.in[1] + (size_t)(r_ - NPROMPT) * DM; \
            _Pragma("unroll") for (int j = 0; j < 8; ++j) XV[j] = ((const f32x4*)xr_)[lane + 64 * j]; } \
        else { const u32x2* xb_ = (const u32x2*)(p.out + OUT_Y + (size_t)r_ * DM); \
            _Pragma("unroll") for (int j = 0; j < 8; ++j) { const u32x2 w_ = xb_[lane + 64 * j]; XV[j] = (f32x4){bflo(w_.x), bfhi(w_.x), bflo(w_.y), bfhi(w_.y)}; } } \
        if (RES) { const u32x2* or_ = (const u32x2*)(outb + (size_t)r_ * DM); _Pragma("unroll") for (int j = 0; j < 8; ++j) OV[j] = or_[lane + 64 * j]; } } while (0)
    int row = gw;
    if (row < NTOK) NORM_LOAD(xa, oa, row);
    while (row < NTOK) {
        const int nrow = row + NGW;
        if (nrow < NTOK) NORM_LOAD(xb, ob, nrow);
        const int ci = cond_of_row(row);
        float ss = 0.f;
#pragma unroll
        for (int j = 0; j < 8; ++j) {
            if (RES) { const f32x4 g = Tg[ci * 512 + lane + 64 * j];
                xa[j][0] += g[0] * bflo(oa[j].x); xa[j][1] += g[1] * bfhi(oa[j].x); xa[j][2] += g[2] * bflo(oa[j].y); xa[j][3] += g[3] * bfhi(oa[j].y); }
            ss += xa[j][0] * xa[j][0] + xa[j][1] * xa[j][1] + xa[j][2] * xa[j][2] + xa[j][3] * xa[j][3]; }
        ss = wave_sum(ss);
        const float rstd = 1.0f / sqrtf(ss * (1.f / DM) + EPS);
        if (MODE == 0) {
            if (RES) { u32x2* xo = (u32x2*)(p.out + OUT_Y + (size_t)row * DM);
#pragma unroll
                for (int j = 0; j < 8; ++j) { u32x2 w; w.x = pk2(xa[j][0], xa[j][1]); w.y = pk2(xa[j][2], xa[j][3]); xo[lane + 64 * j] = w; } }
#pragma unroll
            for (int j = 0; j < 8; ++j) { const int idx = lane + 64 * j; const f32x4 hh = xa[j] * rstd * Tm[idx] * (Ts[ci * 512 + idx] + 1.f) + Tb[ci * 512 + idx];
                u32x2 w; w.x = pk2(hh[0], hh[1]); w.y = pk2(hh[2], hh[3]);
                ((u32x2*)(hbuf + (size_t)row * DM))[idx] = w; }
        } else {
            float* yr = p.out + OUT_Y + (size_t)row * DM;
#pragma unroll
            for (int j = 0; j < 8; ++j) ((f32x4*)yr)[lane + 64 * j] = xa[j] * rstd * Tm[lane + 64 * j];
        }
#pragma unroll
        for (int j = 0; j < 8; ++j) { xa[j] = xb[j]; oa[j] = ob[j]; }
        row = nrow;
    }
#undef NORM_LOAD
}

__device__ __forceinline__ void phase_post0(const Params& p) {
    const int tid = threadIdx.x, lane = tid & 63, wave = tid >> 6;
    const int gw = blockIdx.x * 8 + wave, NGW = gridDim.x * 8;
    u16* z = (u16*)(p.ws + WS_Z);
    const f32x2* rope = (const f32x2*)(p.ws + WS_ROPE0);
    const float* kg = p.in[15];
    const int sub = lane >> 5, cc = lane & 31, head = cc >> 4, c = cc & 15, d0 = c * 8;
    for (int r2 = gw; r2 < NTOK / 2; r2 += NGW) {
        const int row = r2 * 2 + sub;
        u16* zr = z + (size_t)row * LD0 + Z0_K + cc * 8;
        const bool sample = row >= NPROMPT; const int t = (row - NPROMPT) & 4095; const int prow = t >> 6, pcol = t & 63;
        const u32x4 w = *(const u32x4*)zr;
        float f[8]; unpack8(w, f);
        float ss = 0.f;
#pragma unroll
        for (int e = 0; e < 8; ++e) ss += f[e] * f[e];
        ss += __shfl_xor(ss, 1); ss += __shfl_xor(ss, 2); ss += __shfl_xor(ss, 4); ss += __shfl_xor(ss, 8);
        const float rstd = 1.0f / sqrtf(ss * (1.f / 128.f) + EPS);
#pragma unroll
        for (int e = 0; e < 8; ++e) f[e] = f[e] * rstd * kg[d0 + e];
        if (!sample) { float* o = p.out + OUT_K0 + (size_t)row * 256 + head * 128 + d0;
            *(f32x4*)o = (f32x4){f[0], f[1], f[2], f[3]}; *(f32x4*)(o + 4) = (f32x4){f[4], f[5], f[6], f[7]}; }
        if (sample) { const bool first = (c & 4) == 0; const int pos = c < 8 ? prow : pcol; const int i0 = (c & 3) * 8;
#pragma unroll
            for (int e = 0; e < 8; ++e) { const float pf = __shfl_xor(f[e], 4); const f32x2 cs = rope[pos * 32 + i0 + e];
                f[e] = first ? f[e] * cs.x - pf * cs.y : pf * cs.y + f[e] * cs.x; } }
        *(u32x4*)zr = pack8(f);
    }
}
__device__ __forceinline__ void phase_post1(const Params& p) {
    const int tid = threadIdx.x, lane = tid & 63, wave = tid >> 6;
    const int gw = blockIdx.x * 8 + wave, NGW = gridDim.x * 8;
    u16* z = (u16*)(p.ws + WS_Z);
    const f32x2* rope = (const f32x2*)(p.ws + WS_ROPE1);
    for (int row = gw; row < NTOK; row += NGW) {
        u16* zr = z + (size_t)row * LD1;
        if (row < NPROMPT) {
#pragma unroll
            for (int i = 0; i < 8; ++i) { const int cidx = lane + 64 * i;
                const u32x4 w = *(const u32x4*)(zr + Z1_K + cidx * 8); float f[8]; unpack8(w, f);
                float* o = p.out + (cidx < 256 ? OUT_K1 + (size_t)row * 2048 + cidx * 8 : OUT_V1 + (size_t)row * 2048 + (cidx - 256) * 8);
                *(f32x4*)o = (f32x4){f[0], f[1], f[2], f[3]}; *(f32x4*)(o + 4) = (f32x4){f[4], f[5], f[6], f[7]}; }
        } else {
            const int t = (row - NPROMPT) & 4095; const int prow = t >> 6, pcol = t & 63;
#pragma unroll
            for (int i = 0; i < 8; ++i) { const int cidx = lane + 64 * i; const int c = cidx & 7;
                const u32x4 w = *(const u32x4*)(zr + Z1_Q + cidx * 8); float f[8]; unpack8(w, f);
                const bool first = (c & 2) == 0; const int pos = c < 4 ? prow : pcol; const int i0 = (c & 1) * 8;
#pragma unroll
                for (int e = 0; e < 8; ++e) { const float pf = __shfl_xor(f[e], 2); const f32x2 cs = rope[pos * 16 + i0 + e];
                    f[e] = first ? f[e] * cs.x - pf * cs.y : pf * cs.y + f[e] * cs.x; }
                *(u32x4*)(zr + Z1_Q + cidx * 8) = pack8(f); }
        }
    }
}

#define SBAR() do {} while (0)
template <int DQK>
__device__ __forceinline__ void attn_qk32(LAS unsigned char* Kt, const bf16x8 (&qf)[DQK / 16], unsigned kbase, unsigned xr, int kch0, int h, f32x16& s) {
#pragma unroll
    for (int r = 0; r < 16; ++r) s[r] = 0.f;
#pragma unroll
    for (int ks = 0; ks < DQK / 16; ++ks) {
        const unsigned ko = kbase + 16u * (((unsigned)(kch0 + 2 * ks + h)) ^ xr);
        const bf16x8 a = *(const LAS bf16x8*)(Kt + ko);
        s = MFMA32(a, qf[ks], s);
        if (DQK == 128 && ks == 3) SBAR();
    }
}
__device__ __forceinline__ void attn_partial_sm(f32x16& S, float sc, float& m_run, float& alpha, int& resc) {
    float mx = S[0];
#pragma unroll
    for (int r = 1; r < 16; ++r) mx = fmaxf(mx, S[r]);
    { const auto rr = __builtin_amdgcn_permlane32_swap(__float_as_uint(mx), __float_as_uint(mx), false, false);
      mx = fmaxf(__uint_as_float(rr[0]), __uint_as_float(rr[1])); }
    resc = __any((mx - m_run) * sc > 11.5f);
    const float mn = resc ? fmaxf(m_run, mx) : m_run;
    alpha = resc ? __builtin_amdgcn_exp2f((m_run - mn) * sc) : 1.f;
    m_run = mn;
    const float ms = -mn * sc;
#pragma unroll
    for (int r = 0; r < 16; ++r) S[r] = fmaf(S[r], sc, ms);
#pragma unroll
    for (int r = 0; r < 8; ++r) S[r] = __builtin_amdgcn_exp2f(S[r]);
}
__device__ __forceinline__ void attn_finish_sm(f32x16& S, float alpha, float& l_run, bf16x8 (&pb)[2]) {
#pragma unroll
    for (int r = 8; r < 16; ++r) S[r] = __builtin_amdgcn_exp2f(S[r]);
    float rs = 0.f;
#pragma unroll
    for (int r = 0; r < 16; ++r) rs += S[r];
    l_run = l_run * alpha + rs;
#pragma unroll
    for (int s = 0; s < 2; ++s) { u32x4 pw; const int r0 = s * 8;
        pw.x = pk2(S[r0], S[r0 + 1]); pw.y = pk2(S[r0 + 2], S[r0 + 3]); pw.z = pk2(S[r0 + 4], S[r0 + 5]); pw.w = pk2(S[r0 + 6], S[r0 + 7]); pb[s] = __builtin_bit_cast(bf16x8, pw); }
}
__device__ __forceinline__ void attn_pv2(LAS unsigned char* Vt, const unsigned (&vaddr)[2][4], const bf16x8 (&pb)[2], f32x16 (&O)[4]) {
#pragma unroll
    for (int dt = 0; dt < 4; ++dt)
#pragma unroll
        for (int s = 0; s < 2; ++s) {
            const bf16x8 va = tr_pair(Vt + s * 4096 + vaddr[0][dt], Vt + s * 4096 + vaddr[1][dt]);
            O[dt] = MFMA32(va, pb[s], O[dt]);
        }
}
__device__ __forceinline__ void attn_resc(f32x16 (&O)[4], float alpha, int resc) {
    if (resc) {
#pragma unroll
        for (int dt = 0; dt < 4; ++dt) O[dt] *= alpha;
    }
}
__device__ __forceinline__ bf16x8 ones_frag() { u32x4 w; w.x = w.y = w.z = w.w = 0x3F803F80u; return __builtin_bit_cast(bf16x8, w); }
template <int DQK>
__device__ __forceinline__ void attn_qk32_aug(LAS unsigned char* Kt, const bf16x8 (&qf)[DQK / 16], const bf16x8 qaug, unsigned kbase, unsigned xr, int kch0, int h, f32x16& s) {
#pragma unroll
    for (int r = 0; r < 16; ++r) s[r] = 0.f;
    s = MFMA32(ones_frag(), qaug, s);
#pragma unroll
    for (int ks = 0; ks < DQK / 16; ++ks) {
        const unsigned ko = kbase + 16u * (((unsigned)(kch0 + 2 * ks + h)) ^ xr);
        const bf16x8 a = *(const LAS bf16x8*)(Kt + ko);
        s = MFMA32(a, qf[ks], s);
    }
}
__device__ __forceinline__ void attn_partial_sm_aug(f32x16& S, float& m_run, bf16x8& qaug, float& alpha, int& resc, bool force, int h) {
    float mx;
    if (force) {
        mx = S[0];
#pragma unroll
        for (int r = 1; r < 16; ++r) mx = fmaxf(mx, S[r]);
        const auto rr = __builtin_amdgcn_permlane32_swap(__float_as_uint(mx), __float_as_uint(mx), false, false);
        mx = fmaxf(__uint_as_float(rr[0]), __uint_as_float(rr[1]));
        resc = 1;
    } else {
        int mi = __float_as_int(S[0]);
#pragma unroll
        for (int r = 1; r < 16; ++r) mi = max(mi, __float_as_int(S[r]));
        const auto rr = __builtin_amdgcn_permlane32_swap((unsigned)mi, (unsigned)mi, false, false);
        mi = max((int)rr[0], (int)rr[1]);
        mx = __int_as_float(mi);
        resc = __any(mx > 11.5f);
    }
    alpha = 1.f;
    if (__builtin_expect(resc, 0)) {
        asm volatile("" ::: "memory");
        const float d = force ? mx : fmaxf(mx, 0.f);
        const unsigned mb = pk2(m_run + d, 0.f) & 0xffffu;
        const float m_new = __uint_as_float(mb << 16), dd = m_new - m_run;
        alpha = __builtin_amdgcn_exp2f(-dd); m_run = m_new;
#pragma unroll
        for (int r = 0; r < 16; ++r) S[r] -= dd;
        u32x4 qa; qa.x = h == 0 ? (mb ^ 0x8000u) : 0u; qa.y = 0u; qa.z = 0u; qa.w = 0u; qaug = __builtin_bit_cast(bf16x8, qa);
    }
#pragma unroll
    for (int r = 0; r < 8; ++r) S[r] = __builtin_amdgcn_exp2f(S[r]);
}
__device__ __forceinline__ void attn_finish_sm_aug(f32x16& S, bf16x8 (&pb)[2]) {
#pragma unroll
    for (int r = 8; r < 16; ++r) S[r] = __builtin_amdgcn_exp2f(S[r]);
#pragma unroll
    for (int s = 0; s < 2; ++s) { u32x4 pw; const int r0 = s * 8;
        pw.x = pk2(S[r0], S[r0 + 1]); pw.y = pk2(S[r0 + 2], S[r0 + 3]); pw.z = pk2(S[r0 + 4], S[r0 + 5]); pw.w = pk2(S[r0 + 6], S[r0 + 7]); pb[s] = __builtin_bit_cast(bf16x8, pw); }
}
__device__ __forceinline__ void attn_pv2_aug(LAS unsigned char* Vt, const unsigned (&vaddr)[2][4], const bf16x8 (&pb)[2], f32x16 (&O)[4], f32x16& O5) {
    __builtin_amdgcn_s_setprio(1);
#pragma unroll
    for (int dt = 0; dt < 4; ++dt)
#pragma unroll
        for (int s = 0; s < 2; ++s) {
            const bf16x8 va = tr_pair(Vt + s * 4096 + vaddr[0][dt], Vt + s * 4096 + vaddr[1][dt]);
            O[dt] = MFMA32(va, pb[s], O[dt]);
        }
    O5 = MFMA32(ones_frag(), pb[0], O5); O5 = MFMA32(ones_frag(), pb[1], O5);
    __builtin_amdgcn_s_setprio(0);
}
__device__ __forceinline__ void attn_resc_aug(f32x16 (&O)[4], f32x16& O5, float alpha, int resc) {
    if (resc) {
#pragma unroll
        for (int dt = 0; dt < 4; ++dt) O[dt] *= alpha;
        O5 *= alpha;
    }
}
template <int DQK, bool AUG>
__device__ __forceinline__ void attn_core(LAS unsigned char* lds, const bf16x8 (&qf)[DQK / 16],
                                          const u16* kown, const u16* vown, int ldo, int n_own,
                                          const u16* kc, const u16* vc, int ldc, int n_cache, int kch0, float sc,
                                          f32x16 (&O)[4], float& m_run, float& l_run) {
    const int tid = threadIdx.x, lane = tid & 63, wave = __builtin_amdgcn_readfirstlane(tid >> 6), h = lane >> 5, l31 = lane & 31;
    const int ntiles = n_own + n_cache;
    unsigned go_own[2], go_c[2];
#pragma unroll
    for (int i = 0; i < 2; ++i) { const unsigned row = 8u * wave + 4u * i + (lane >> 4); const unsigned ch = (lane & 15u) ^ ((((unsigned)lane >> 4) << 2) | ((2u * wave + i) & 3u));
        go_own[i] = row * (unsigned)ldo + ch * 8u; go_c[i] = row * (unsigned)ldc + ch * 8u; }
    const unsigned ldsw = 2048u * wave;
#define ATT_STAGE(own, cch, t, bufoff) do { const bool o_ = (t) < n_own; \
        const u16* b_ = o_ ? (own) + (size_t)(t) * 64 * ldo : (cch) + (size_t)((t) - n_own) * 64 * ldc; \
        const unsigned g0_ = o_ ? go_own[0] : go_c[0], g1_ = o_ ? go_own[1] : go_c[1]; \
        dma16(b_ + g0_, lds + (bufoff) + ldsw); dma16(b_ + g1_, lds + (bufoff) + ldsw + 1024); } while (0)
#define ATT_SYNC() do { asm volatile("s_waitcnt vmcnt(0)" ::: "memory"); __syncthreads(); } while (0)
    const unsigned xr = ((l31 & 3u) << 2) | ((l31 >> 2) & 3u), kbase = 256u * l31;
    const unsigned blk = (lane >> 4) & 1, q4 = (lane & 15) >> 2, p2 = lane & 3;
    unsigned vaddr[2][4];
#pragma unroll
    for (int t = 0; t < 2; ++t)
#pragma unroll
        for (int dt = 0; dt < 4; ++dt) vaddr[t][dt] = off_b(8 * t + 4 * h + q4, 4 * dt + 2 * blk + (p2 >> 1)) + 8 * (p2 & 1);
    int kcur = 0, knext = 16384, kfree = 32768, vcur = 49152, vnext = 65536;
    ATT_STAGE(kown, kc, 0, kcur); ATT_STAGE(vown, vc, 0, vcur); ATT_STAGE(kown, kc, 1, knext);
    ATT_SYNC();
    f32x16 A, B; bf16x8 pb[2]; float alA, alB; int rsA, rsB;
    f32x16 O5; bf16x8 qaug;
#pragma unroll
    for (int r = 0; r < 16; ++r) O5[r] = 0.f;
    { u32x4 zq; zq.x = zq.y = zq.z = zq.w = 0u; qaug = __builtin_bit_cast(bf16x8, zq); }
#define A_QK(Kp, S_) do { if (AUG) attn_qk32_aug<DQK>(Kp, qf, qaug, kbase, xr, kch0, h, S_); else attn_qk32<DQK>(Kp, qf, kbase, xr, kch0, h, S_); } while (0)
#define A_PART(S_, al_, rs_, force_) do { if (AUG) attn_partial_sm_aug(S_, m_run, qaug, al_, rs_, force_, h); else attn_partial_sm(S_, sc, m_run, al_, rs_); } while (0)
#define A_FIN(S_, al_) do { if (AUG) attn_finish_sm_aug(S_, pb); else attn_finish_sm(S_, al_, l_run, pb); } while (0)
#define A_PV(Vp) do { if (AUG) attn_pv2_aug(Vp, vaddr, pb, O, O5); else attn_pv2(Vp, vaddr, pb, O); } while (0)
#define A_RESC(al_, rs_) do { if (AUG) attn_resc_aug(O, O5, al_, rs_); else attn_resc(O, al_, rs_); } while (0)
    A_QK(lds + kcur, A);
    A_PART(A, alA, rsA, true);
    for (int t = 0; t + 1 < ntiles; ++t) {
        ATT_STAGE(vown, vc, t + 1, vnext);
        if (t + 2 < ntiles) ATT_STAGE(kown, kc, t + 2, kfree);
        SBAR(); A_QK(lds + kcur + 8192, B);
        A_FIN(A, alA); SBAR();
        A_PV(lds + vcur); A_PART(B, alB, rsB, false);
        A_RESC(alB, rsB);
        SBAR(); A_QK(lds + knext, A);
        A_FIN(B, alB); SBAR();
        A_PV(lds + vcur + 8192); A_PART(A, alA, rsA, false);
        ATT_SYNC(); A_RESC(alA, rsA);
        { const int tmp = kcur; kcur = knext; knext = kfree; kfree = tmp; const int tv = vcur; vcur = vnext; vnext = tv; }
    }
    SBAR(); A_QK(lds + kcur + 8192, B);
    A_FIN(A, alA); SBAR();
    A_PV(lds + vcur); A_PART(B, alB, rsB, false);
    A_RESC(alB, rsB);
    A_FIN(B, alB); SBAR();
    A_PV(lds + vcur + 8192);
    if (AUG) l_run = O5[0];
    __syncthreads();
#undef A_QK
#undef A_PART
#undef A_FIN
#undef A_PV
#undef A_RESC
#undef ATT_STAGE
#undef ATT_SYNC
}

__device__ __forceinline__ float silu_fast(float v) { return v * __builtin_amdgcn_rcpf(1.f + __builtin_amdgcn_exp2f(-v * LOG2E)); }
template <int NROWS>
__device__ __forceinline__ void attn_gate_store(LAS unsigned char* ybase, const u16* gate0, int ldg, u16* y0) {
    const int tid = threadIdx.x;
#pragma unroll 2
    for (int i = 0; i < NROWS / 32; ++i) { const int n = tid + 512 * i, row = n >> 4, c = n & 15;
        const u32x4 tw = *(const LAS u32x4*)(ybase + (row >> 5) * 8704 + (row & 31) * 272 + c * 16);
        const u32x4 gw = *(const u32x4*)(gate0 + (size_t)row * ldg + c * 8);
        float t[8], g[8]; unpack8(tw, t); unpack8(gw, g);
#pragma unroll
        for (int e = 0; e < 8; ++e) t[e] *= silu_fast(g[e]);
        *(u32x4*)(y0 + (size_t)row * DM + c * 8) = pack8(t); }
}

__device__ __forceinline__ void gqa_item(const Params& p, LAS unsigned char* lds, int qtok0, int hq, int ktok0, int n_own, int cache_b) {
    const int tid = threadIdx.x, lane = tid & 63, wave = tid >> 6, h = lane >> 5, l31 = lane & 31;
    const u16* z = (const u16*)(p.ws + WS_Z);
    const int kvh = hq >> 2;
    const int qtok = qtok0 + wave * 32 + l31;
    bf16x8 qf[8];
    {
        float qv[8][8]; float ss = 0.f;
#pragma unroll
        for (int ks = 0; ks < 8; ++ks) { const u32x4 w = *(const u32x4*)(z + (size_t)qtok * LD0 + Z0_Q + hq * 128 + ks * 16 + h * 8); unpack8(w, qv[ks]);
#pragma unroll
            for (int j = 0; j < 8; ++j) ss += qv[ks][j] * qv[ks][j]; }
        { const auto rr = __builtin_amdgcn_permlane32_swap(__float_as_uint(ss), __float_as_uint(ss), false, false); ss = __uint_as_float(rr[0]) + __uint_as_float(rr[1]); }
        const float rstd = 1.0f / sqrtf(ss * (1.f / 128.f) + EPS);
        const float* qg = p.in[14];
#pragma unroll
        for (int ks = 0; ks < 8; ++ks) { const f32x4 g0 = *(const f32x4*)(qg + ks * 16 + h * 8), g1 = *(const f32x4*)(qg + ks * 16 + h * 8 + 4);
#pragma unroll
            for (int j = 0; j < 8; ++j) qv[ks][j] *= (rstd * (0.08838834764831845f * LOG2E)) * (j < 4 ? g0[j & 3] : g1[j & 3]); }
        if (cache_b >= 0) { const int t = (qtok - NPROMPT) & 4095; const f32x2* rope = (const f32x2*)(p.ws + WS_ROPE0);
#pragma unroll
            for (int kp = 0; kp < 4; ++kp) { const int k1 = (kp >> 1) * 4 + (kp & 1), k2 = k1 + 2;
                const int pos = kp < 2 ? (t >> 6) : (t & 63); const f32x4* rp = (const f32x4*)(rope + pos * 32 + 16 * (k1 & 1) + 8 * h);
#pragma unroll
                for (int q = 0; q < 4; ++q) { const f32x4 cs = rp[q];
                    { const float a = qv[k1][2 * q], b = qv[k2][2 * q]; qv[k1][2 * q] = a * cs[0] - b * cs[1]; qv[k2][2 * q] = a * cs[1] + b * cs[0]; }
                    { const float a = qv[k1][2 * q + 1], b = qv[k2][2 * q + 1]; qv[k1][2 * q + 1] = a * cs[2] - b * cs[3]; qv[k2][2 * q + 1] = a * cs[3] + b * cs[2]; } } } }
#pragma unroll
        for (int ks = 0; ks < 8; ++ks) qf[ks] = __builtin_bit_cast(bf16x8, pack8(qv[ks]));
    }
    f32x16 O[4];
#pragma unroll
    for (int dt = 0; dt < 4; ++dt)
#pragma unroll
        for (int r = 0; r < 16; ++r) O[dt][r] = 0.f;
    float m_run = 0.f, l_run = 0.f;
    const u16* kc = (const u16*)(p.ws + WS_CK0) + (size_t)(cache_b < 0 ? 0 : cache_b) * 256 * 256 + kvh * 128;
    const u16* vc = (const u16*)(p.ws + WS_CV0) + (size_t)(cache_b < 0 ? 0 : cache_b) * 256 * 256 + kvh * 128;
    attn_core<128, true>(lds, qf, z + (size_t)ktok0 * LD0 + Z0_K + kvh * 128, z + (size_t)ktok0 * LD0 + Z0_V + kvh * 128, LD0, n_own,
                   kc, vc, 256, cache_b < 0 ? 0 : 4, 0, 1.f, O, m_run, l_run);
    const float inv = 1.f / l_run;
    LAS unsigned char* yb = lds + wave * 8704 + l31 * 272;
#pragma unroll
    for (int dt = 0; dt < 4; ++dt)
#pragma unroll
        for (int rg = 0; rg < 4; ++rg) { const int d0 = dt * 32 + rg * 8 + 4 * h;
            u32x2 o; o.x = pk2(O[dt][rg * 4 + 0] * inv, O[dt][rg * 4 + 1] * inv); o.y = pk2(O[dt][rg * 4 + 2] * inv, O[dt][rg * 4 + 3] * inv);
            *(LAS u32x2*)(yb + d0 * 2) = o; }
    __syncthreads();
    attn_gate_store<256>(lds, z + (size_t)qtok0 * LD0 + Z0_GB + hq * 128, LD0, (u16*)(p.ws + WS_A) + (size_t)qtok0 * DM + 1024 + hq * 128);
    __syncthreads();
}

__device__ __forceinline__ void gate_item(const Params& p, LAS unsigned char* lds, int chunk, int gh) {
    const int tid = threadIdx.x, lane = tid & 63, wave = tid >> 6, h = lane >> 5, l31 = lane & 31;
    const u16* z = (const u16*)(p.ws + WS_Z);
    const int tok0 = chunk * 128;
    LAS unsigned char* VN = lds; LAS unsigned char* WSb = lds + 32768; LAS f32x2* ST = (LAS f32x2*)(lds + 65536);
    {
        const int tk = tid >> 2, part = tid & 3; const u16* src = z + (size_t)(tok0 + tk) * LD0 + Z0_VA + part * 256;
        float s = 0.f, s2 = 0.f;
#pragma unroll 8
        for (int i = 0; i < 32; ++i) { const u32x4 w = *(const u32x4*)(src + i * 8); float f[8]; unpack8(w, f);
#pragma unroll
            for (int e = 0; e < 8; ++e) { s += f[e]; s2 += f[e] * f[e]; } }
        s += __shfl_xor(s, 1); s2 += __shfl_xor(s2, 1); s += __shfl_xor(s, 2); s2 += __shfl_xor(s2, 2);
        const float mu = s * (1.f / 1024.f); const float var = fmaxf(s2 * (1.f / 1024.f) - mu * mu, 0.f);
        if (part == 0) { f32x2 st; st.x = mu; st.y = 1.0f / sqrtf(var + EPS); ST[tk] = st; }
    }
    __syncthreads();
    const int ct = wave >> 1, pt0 = (wave & 1) * 2;
    const unsigned blk = (lane >> 4) & 1, q4 = (lane & 15) >> 2, p2 = lane & 3;
    u16* ycat = (u16*)(p.ws + WS_A);
    for (int g = gh * 4; g < gh * 4 + 4; ++g) {
#pragma unroll
        for (int i = 0; i < 4; ++i) { const int n = tid + 512 * i, row = n >> 4, ch = n & 15;
            const u32x4 w = *(const u32x4*)(z + (size_t)(tok0 + row) * LD0 + Z0_VA + g * 128 + ch * 8); const f32x2 st = ST[row];
            float f[8]; unpack8(w, f);
#pragma unroll
            for (int e = 0; e < 8; ++e) f[e] = (f[e] - st.x) * st.y;
            *(LAS u32x4*)(VN + off_b(row, ch)) = pack8(f);
            const float* wsrc = p.in[12] + (size_t)g * 16384 + row * 128 + ch * 8;
            const f32x4 w0 = *(const f32x4*)wsrc, w1 = *(const f32x4*)(wsrc + 4);
            u32x4 o; o.x = pk2(w0[0], w0[1]); o.y = pk2(w0[2], w0[3]); o.z = pk2(w1[0], w1[1]); o.w = pk2(w1[2], w1[3]);
            *(LAS u32x4*)(WSb + off_b(row, ch)) = o; }
        __syncthreads();
        f32x16 acc[2];
#pragma unroll
        for (int r = 0; r < 16; ++r) { acc[0][r] = 0.f; acc[1][r] = 0.f; }
#pragma unroll
        for (int ks = 0; ks < 8; ++ks) {
            const unsigned a0 = off_b(16 * ks + 8 * h + q4, 4 * ct + 2 * blk + (p2 >> 1)) + 8 * (p2 & 1);
            const unsigned a1 = off_b(16 * ks + 8 * h + 4 + q4, 4 * ct + 2 * blk + (p2 >> 1)) + 8 * (p2 & 1);
            const bf16x8 A = tr_pair(VN + a0, VN + a1);
#pragma unroll
            for (int i = 0; i < 2; ++i) { const bf16x8 B = *(const LAS bf16x8*)(WSb + off_b((pt0 + i) * 32 + l31, 2 * ks + h)); acc[i] = MFMA32(A, B, acc[i]); }
        }
        LAS unsigned char* Yb = lds + 69632;
#pragma unroll
        for (int i = 0; i < 2; ++i) { const int pp = (pt0 + i) * 32 + l31; const float bs = p.in[13][g * 128 + pp];
            LAS unsigned char* yb = Yb + (pt0 + i) * 8704 + l31 * 272;
#pragma unroll
            for (int rg = 0; rg < 4; ++rg) { const int c0 = ct * 32 + rg * 8 + 4 * h;
                u32x2 o; o.x = pk2(acc[i][rg * 4 + 0] + bs, acc[i][rg * 4 + 1] + bs); o.y = pk2(acc[i][rg * 4 + 2] + bs, acc[i][rg * 4 + 3] + bs);
                *(LAS u32x2*)(yb + c0 * 2) = o; } }
        __syncthreads();
#pragma unroll
        for (int i = 0; i < 4; ++i) { const int n = tid + 512 * i, row = n >> 4, c = n & 15;
            const u32x4 sw = *(const LAS u32x4*)(Yb + (row >> 5) * 8704 + (row & 31) * 272 + c * 16);
            const u16* zr = z + (size_t)(tok0 + row) * LD0 + g * 128 + c * 8;
            const u32x4 uw = *(const u32x4*)(zr + Z0_U), gw = *(const u32x4*)(zr + Z0_GA);
            float s[8], u[8], ga[8]; unpack8(sw, s); unpack8(uw, u); unpack8(gw, ga);
#pragma unroll
            for (int e = 0; e < 8; ++e) s[e] = u[e] * s[e] * silu_fast(ga[e]);
            *(u32x4*)(ycat + (size_t)(tok0 + row) * DM + g * 128 + c * 8) = pack8(s); }
        __syncthreads();
    }
}

__device__ __forceinline__ void phase_mix0(const Params& p, LAS unsigned char* lds) {
    for (int it = blockIdx.x; it < 512; it += gridDim.x) {
        int qtok0, hq, ktok0, n_own, cb;
        if (it < 256) {
            const int x = it & 7, i = it >> 3, pair = x & 3, b = pair >> 1, kvh = pair & 1, sub = (x >> 2) * 32 + i;
            hq = kvh * 4 + (sub >> 4); qtok0 = NPROMPT + b * 4096 + (sub & 15) * 256; ktok0 = NPROMPT + b * 4096; n_own = 64; cb = b; }
        else { const int r = it - 256, i = r >> 3; hq = r & 7; qtok0 = i * 256; ktok0 = i * 256; n_own = 4; cb = -1; }
        gqa_item(p, lds, qtok0, hq, ktok0, n_own, cb);
    }
    for (int it = blockIdx.x; it < 256; it += gridDim.x) gate_item(p, lds, it >> 1, it & 1);
}

__device__ __forceinline__ void diff_item(const Params& p, LAS unsigned char* lds, int qtok0, int hd, int ktok0, int n_own, int cache_b, float lam) {
    const int tid = threadIdx.x, lane = tid & 63, wave = tid >> 6, h = lane >> 5, l31 = lane & 31;
    const u16* z = (const u16*)(p.ws + WS_Z);
    const int map = wave & 1, qt = wave >> 1;
    const int qtok = qtok0 + qt * 32 + l31;
    bf16x8 qf[4];
#pragma unroll
    for (int ks = 0; ks < 4; ++ks) qf[ks] = *(const bf16x8*)(z + (size_t)qtok * LD1 + Z1_Q + hd * 128 + map * 64 + ks * 16 + h * 8);
    f32x16 O[4];
#pragma unroll
    for (int dt = 0; dt < 4; ++dt)
#pragma unroll
        for (int r = 0; r < 16; ++r) O[dt][r] = 0.f;
    float m_run = 0.f, l_run = 0.f;
    const u16* kc = (const u16*)(p.ws + WS_CK1) + (size_t)(cache_b < 0 ? 0 : cache_b) * 256 * LDC1 + hd * 128;
    const u16* vc = (const u16*)(p.ws + WS_CV1) + (size_t)(cache_b < 0 ? 0 : cache_b) * 256 * LDC1 + hd * 128;
    attn_core<64, true>(lds, qf, z + (size_t)ktok0 * LD1 + Z1_K + hd * 128, z + (size_t)ktok0 * LD1 + Z1_V + hd * 128, LD1, n_own,
                  kc, vc, LDC1, cache_b < 0 ? 0 : 4, map * 8, 1.f, O, m_run, l_run);
    const float inv = 1.f / l_run;
    LAS float* X = (LAS float*)(lds + qt * 16384);
    if (map == 1) {
        const float s = inv * lam;
#pragma unroll
        for (int dt = 0; dt < 4; ++dt)
#pragma unroll
            for (int r = 0; r < 16; ++r) X[(dt * 16 + r) * 64 + lane] = O[dt][r] * s;
    }
    __syncthreads();
    if (map == 0) {
        float ss = 0.f;
#pragma unroll
        for (int dt = 0; dt < 4; ++dt)
#pragma unroll
            for (int r = 0; r < 16; ++r) { const float o = O[dt][r] * inv - X[(dt * 16 + r) * 64 + lane]; O[dt][r] = o; ss += o * o; }
        ss += __shfl_xor(ss, 32);
        const float rstd = (1.f - LAMBDA_INIT) / sqrtf(ss * (1.f / 128.f) + EPS);
        LAS unsigned char* yb = lds + 65536 + qt * 8704 + l31 * 272;
        const float* sg = p.in[25];
#pragma unroll
        for (int dt = 0; dt < 4; ++dt)
#pragma unroll
            for (int rg = 0; rg < 4; ++rg) { const int d0 = dt * 32 + rg * 8 + 4 * h;
                const f32x4 s4 = *(const f32x4*)(sg + d0);
                u32x2 o; o.x = pk2(O[dt][rg * 4 + 0] * rstd * s4[0], O[dt][rg * 4 + 1] * rstd * s4[1]);
                o.y = pk2(O[dt][rg * 4 + 2] * rstd * s4[2], O[dt][rg * 4 + 3] * rstd * s4[3]);
                *(LAS u32x2*)(yb + d0 * 2) = o; }
    }
    __syncthreads();
    attn_gate_store<128>(lds + 65536, z + (size_t)qtok0 * LD1 + Z1_G + hd * 128, LD1, (u16*)(p.ws + WS_A) + (size_t)qtok0 * DM + hd * 128);
    __syncthreads();
}
__device__ __forceinline__ void phase_mix1(const Params& p, LAS unsigned char* lds) {
    const int lane = threadIdx.x & 63;
    const float d1 = wave_sum(p.in[21][lane] * p.in[22][lane]), d2 = wave_sum(p.in[23][lane] * p.in[24][lane]);
    const float lam = expf(d1) - expf(d2) + LAMBDA_INIT;
    for (int it = blockIdx.x; it < 2048; it += gridDim.x) {
        int qtok0, hd, ktok0, n_own, cb;
        if (it < 1024) {
            const int x = it & 7, i = (it >> 3) & 31, r = it >> 8, pair = r * 8 + x, b = pair >> 4;
            hd = pair & 15; qtok0 = NPROMPT + b * 4096 + i * 128; ktok0 = NPROMPT + b * 4096; n_own = 64; cb = b; }
        else { const int r = it - 1024, i = r >> 5; hd = (r >> 1) & 15; qtok0 = i * 256 + (r & 1) * 128; ktok0 = i * 256; n_own = 4; cb = -1; }
        diff_item(p, lds, qtok0, hd, ktok0, n_own, cb, lam);
    }
}

__device__ __forceinline__ void grid_barrier(unsigned* bar, unsigned k) {
    __syncthreads();
    if (threadIdx.x == 0) {
        __builtin_amdgcn_fence(__ATOMIC_RELEASE, "agent");
        asm volatile("s_waitcnt vmcnt(0) lgkmcnt(0)" ::: "memory");
        const unsigned G = gridDim.x, nsh = G < 8u ? G : 8u, sh = blockIdx.x % nsh, per = (G - sh + nsh - 1) / nsh;
        const unsigned old = __hip_atomic_fetch_add(bar + 64 * (1 + sh), 1u, __ATOMIC_RELAXED, __HIP_MEMORY_SCOPE_AGENT);
        if (old + 1 == k * per) __hip_atomic_fetch_add(bar, 1u, __ATOMIC_RELAXED, __HIP_MEMORY_SCOPE_AGENT);
        while (__hip_atomic_load(bar, __ATOMIC_RELAXED, __HIP_MEMORY_SCOPE_AGENT) < k * nsh) __builtin_amdgcn_s_sleep(1);
        __builtin_amdgcn_fence(__ATOMIC_ACQUIRE, "agent");
        asm volatile("s_waitcnt vmcnt(0) lgkmcnt(0)" ::: "memory");
    }
    __syncthreads();
}

__global__ __launch_bounds__(512, 2) void mega_fwd(Params p) {
    extern __shared__ __attribute__((aligned(16))) unsigned char smem[];
    LAS unsigned char* lds = (LAS unsigned char*)smem;
    cg::grid_group grid = cg::this_grid();
#define PH_ON(n) (p.ph_lo <= (n) && (n) < p.ph_hi)
#define PH_SYNC(n) do { if (p.ph_lo <= (n) && (n) + 1 < p.ph_hi) { if ((n) == 0) grid.sync(); else { bar_target += 1; grid_barrier(bar_ctr, bar_target); } } } while (0)
    unsigned* bar_ctr = (unsigned*)(p.ws + WS_BAR); unsigned bar_target = 0;
#define GEMM_IN(WOFF, NN, LDZ) do { pg8::Gemm g; g.A = (const u16*)(p.ws + WS_A); g.Bt = (const u16*)(p.ws + (WOFF)); g.M = NTOK; g.N = (NN); g.K = DM; \
        pg8::StaticOrder S; S.init(g.M, g.N, gridDim.x, blockIdx.x); pg8::EpiBf16 E; E.O = (u16*)(p.ws + WS_Z); E.ldc = (LDZ); pg8::gemm_phase(lds, g, S, E); } while (0)
#define GEMM_OUT(WOFF, XA, XB, LAYER) do { pg8::Gemm g; g.A = (const u16*)(p.ws + WS_A); g.Bt = (const u16*)(p.ws + (WOFF)); g.M = NTOK; g.N = DM; g.K = DM; \
        pg8::StaticOrder S; S.init(g.M, g.N, gridDim.x, blockIdx.x); pg8::EpiResid E; E.xa = (XA); E.xb = (XB); E.xout = p.out + OUT_Y; \
        E.gate = (const float*)(p.ws + WS_MOD) + (LAYER) * 3 * 6144 + 4096; pg8::gemm_phase(lds, g, S, E); } while (0)
    if (PH_ON(0)) phase_prep(p, lds);
    PH_SYNC(0);
    if (PH_ON(1)) phase_norm<0, false>(p, 0, lds);
    PH_SYNC(1);
    if (PH_ON(2)) { pg8::Gemm g; g.A = (const u16*)(p.ws + WS_A); g.Bt = (const u16*)(p.ws + WS_WIN0); g.M = NTOK; g.N = IN0; g.K = DM;
        pg8::StaticOrder S; S.init(g.M, g.N, gridDim.x, blockIdx.x); pg8::EpiIn0 E; E.O = (u16*)(p.ws + WS_Z); E.ldc = LD0; E.outv = p.out + OUT_V0; pg8::gemm_phase(lds, g, S, E);
        { const int nwg = (NTOK / 256) * (IN0 / 256), G = (int)gridDim.x, rem = nwg % G;
          if (rem == 0) prep_w1(p, lds, blockIdx.x, G); else if ((int)blockIdx.x >= rem) prep_w1(p, lds, blockIdx.x - rem, G - rem); } }
    PH_SYNC(2);
    if (PH_ON(3)) phase_post0(p);
    PH_SYNC(3);
    if (PH_ON(4)) phase_mix0(p, lds);
    PH_SYNC(4);
    if (PH_ON(5)) GEMM_IN(WS_WOUT0, DM, DM);
    PH_SYNC(5);
    if (PH_ON(6)) phase_norm<0, true>(p, 1, lds);
    PH_SYNC(6);
    if (PH_ON(7)) { pg8::Gemm g; g.A = (const u16*)(p.ws + WS_A); g.Bt = (const u16*)(p.ws + WS_WIN1); g.M = NTOK; g.N = IN1; g.K = DM;
        pg8::StaticOrder S; S.init(g.M, g.N, gridDim.x, blockIdx.x); pg8::EpiIn1 E; E.O = (u16*)(p.ws + WS_Z); E.ldc = LD1;
        E.outk = p.out + OUT_K1; E.outv = p.out + OUT_V1; E.rope = (const f32x2*)(p.ws + WS_ROPE1); pg8::gemm_phase(lds, g, S, E); }
    PH_SYNC(7);
    if (PH_ON(9)) phase_mix1(p, lds);
    PH_SYNC(9);
    if (PH_ON(10)) GEMM_IN(WS_WOUT1, DM, DM);
    PH_SYNC(10);
    if (PH_ON(11)) phase_norm<1, true>(p, 1, lds);
}

extern "C" void kernel_launch(void* const* d_in, const int* in_sizes, int n_in, void* d_out, int out_size, void* d_ws, size_t ws_size, hipStream_t stream) {
    static int grid = 0;
    if (grid == 0) {
        if (n_in != 28 || ws_size < WS_END) { fprintf(stderr, "kernel_launch: unexpected n_in %d or ws_size %zu (< %zu)\n", n_in, ws_size, (size_t)WS_END); grid = -1; return; }
        int dev = 0, cus = 0, per_cu = 0;
        hipGetDevice(&dev);
        hipDeviceGetAttribute(&cus, hipDeviceAttributeMultiprocessorCount, dev);
        hipFuncSetAttribute((const void*)mega_fwd, hipFuncAttributeMaxDynamicSharedMemorySize, LDS_BYTES);
        hipOccupancyMaxActiveBlocksPerMultiprocessor(&per_cu, (const void*)mega_fwd, 512, LDS_BYTES);
        if (per_cu < 1) per_cu = 1;
        grid = cus * per_cu;
        if (grid > 256) grid = 256;
    }
    if (grid < 0) return;
    if (hipMemsetAsync((char*)d_ws + WS_BAR, 0, 4096, stream) != hipSuccess) { fprintf(stderr, "kernel_launch: memset of the barrier word failed\n"); return; }
    Params p{};
    for (int i = 0; i < 28; ++i) p.in[i] = (const float*)d_in[i];
    p.out = (float*)d_out; p.ws = (unsigned char*)d_ws; p.ph_lo = 0; p.ph_hi = 12;
    void* args[] = {&p};
    hipError_t e = hipLaunchCooperativeKernel((const void*)mega_fwd, dim3(grid), dim3(512), args, LDS_BYTES, stream);
    if (e != hipSuccess) fprintf(stderr, "cooperative launch failed: %s (grid %d)\n", hipGetErrorString(e), grid);
}
```

```cpp
#include <hip/hip_runtime.h>
#include <hip/hip_cooperative_groups.h>
#include <cstdio>
namespace cg = cooperative_groups;

#define LAS __attribute__((address_space(3)))
typedef unsigned short u16;
typedef short bf16x8 __attribute__((ext_vector_type(8)));
typedef short s16x4 __attribute__((ext_vector_type(4)));
typedef float f32x2 __attribute__((ext_vector_type(2)));
typedef float f32x4 __attribute__((ext_vector_type(4)));
typedef float f32x16 __attribute__((ext_vector_type(16)));
typedef unsigned u32x2 __attribute__((ext_vector_type(2)));
typedef unsigned u32x4 __attribute__((ext_vector_type(4)));
typedef __bf16 bf2_t __attribute__((ext_vector_type(2)));

constexpr int NTOK = 16384, NPROMPT = 8192, DM = 2048, IN0 = 5632, IN1 = 8192;
constexpr int LD0 = IN0 + 128, LD1 = IN1 + 128, LDC1 = 2048 + 128;
constexpr int Z0_U = 0, Z0_VA = 1024, Z0_GA = 2048, Z0_Q = 3072, Z0_K = 4096, Z0_V = 4352, Z0_GB = 4608;
constexpr int Z1_Q = 0, Z1_K = 2048, Z1_V = 4096, Z1_G = 6144;
constexpr float EPS = 1e-6f;
constexpr float LAMBDA_INIT = 0.35550906759096926f;
constexpr float LOG2E = 1.4426950408889634f;

constexpr size_t OUT_Y = 0, OUT_K0 = 33554432, OUT_V0 = 35651584, OUT_K1 = 37748736, OUT_V1 = 54525952;
constexpr size_t WS_MOD = 0, WS_ROPE0 = 262144, WS_ROPE1 = 278528, WS_CK0 = 327680, WS_CV0 = 589824, WS_CK1 = 851968, WS_CV1 = 851968 + 2228224;
constexpr size_t WS_WIN1 = 5373952, WS_WOUT1 = WS_WIN1 + 33554432, WS_A = WS_WOUT1 + 8388608, WS_Z = WS_A + 67108864;
constexpr size_t WS_WIN0 = WS_Z + (size_t)NTOK * LD0 * 2, WS_WOUT0 = WS_WIN0 + 23068672, WS_END = WS_Z + (size_t)NTOK * LD1 * 2;
static_assert(WS_CV1 + 2228224 <= WS_WIN1 && WS_END <= 391000000 && WS_WOUT0 + 8388608 <= WS_END, "workspace map");
constexpr int LDS_BYTES = 131072;
constexpr size_t WS_BAR = 229376;

struct Params {
    const float* in[28];
    float* out;
    unsigned char* ws;
    int ph_lo, ph_hi;
};

__device__ __forceinline__ unsigned pk2(float lo, float hi) { f32x2 v = {lo, hi}; bf2_t b = __builtin_convertvector(v, bf2_t); return __builtin_bit_cast(unsigned, b); }
__device__ __forceinline__ float bflo(unsigned w) { return __uint_as_float(w << 16); }
__device__ __forceinline__ float bfhi(unsigned w) { return __uint_as_float(w & 0xffff0000u); }
__device__ __forceinline__ void unpack8(const u32x4 w, float (&f)[8]) {
    f[0] = bflo(w.x); f[1] = bfhi(w.x); f[2] = bflo(w.y); f[3] = bfhi(w.y); f[4] = bflo(w.z); f[5] = bfhi(w.z); f[6] = bflo(w.w); f[7] = bfhi(w.w);
}
__device__ __forceinline__ u32x4 pack8(const float (&f)[8]) { u32x4 w; w.x = pk2(f[0], f[1]); w.y = pk2(f[2], f[3]); w.z = pk2(f[4], f[5]); w.w = pk2(f[6], f[7]); return w; }
__device__ __forceinline__ float wave_sum(float v) {
#pragma unroll
    for (int o = 1; o < 64; o <<= 1) v += __shfl_xor(v, o);
    return v;
}
__device__ __forceinline__ float silu_f(float v) { return v / (1.f + __expf(-v)); }
__device__ __forceinline__ int cond_of_row(int row) { return row < NPROMPT ? 0 : 1 + ((row - NPROMPT) >> 12); }
__device__ __forceinline__ unsigned off_b(unsigned row, unsigned ch) { return 256u * row + 16u * (ch ^ (((row & 3u) << 2) | ((row >> 2) & 3u))); }
#define MFMA32(a, b, c) __builtin_amdgcn_mfma_f32_32x32x16_bf16((a), (b), (c), 0, 0, 0)
__device__ __forceinline__ bf16x8 tr_pair(LAS unsigned char* p0, LAS unsigned char* p1) {
    const s16x4 a = __builtin_amdgcn_ds_read_tr16_b64_v4i16((LAS s16x4*)p0);
    const s16x4 b = __builtin_amdgcn_ds_read_tr16_b64_v4i16((LAS s16x4*)p1);
    return __builtin_shufflevector(a, b, 0, 1, 2, 3, 4, 5, 6, 7);
}

__device__ __forceinline__ void dma16(const void* g, LAS unsigned char* l) {
    asm volatile("s_mov_b32 m0, %0\n\ts_nop 0\n\tglobal_load_lds_dwordx4 %1, off" :: "s"((unsigned)(size_t)l), "v"(g) : "memory", "m0");
}

namespace pg8 {
typedef unsigned short bf16_t;
constexpr int BM = 256, BK = 64, HALF = 128, HTB = HALF * BK * 2, STAGE_BYTES = 8 * HTB, NXCD = 8, WGM = 8;
__device__ __forceinline__ int lds_byte(int r, int c) { const int st = (r >> 4) * 2 + (c >> 5), rr = r & 15, cc = c & 31, ob = rr * 64 + cc * 2; return st * 1024 + (ob ^ (((ob >> 9) & 1) << 5)); }
__device__ __forceinline__ void stage_rc(int b, int& R, int& C) { const int st = b / 1024, sb = b % 1024, swz = sb ^ (((sb >> 9) & 1) << 5); R = (st >> 1) * 16 + swz / 64; C = (st & 1) * 32 + (swz % 64) / 2; }
__device__ __forceinline__ int perm32(int rho) { const int n = rho >> 4, i = rho & 15; return 8 * (i >> 2) + 4 * n + (i & 3); }
struct Unit { int pm, pn; };
struct Gemm { const bf16_t* A; const bf16_t* Bt; int M, N, K; };
struct StaticOrder {
    int nM, nN, nwg, G, c;
    __device__ void init(int M, int N, int G_, int c_) { nM = M / BM; nN = N / BM; nwg = nM * nN; G = G_; c = c_; }
    __device__ bool next(int i, Unit& u) const {
        const long L = (long)i * G + c; if (L >= nwg) return false;
        int wgid = (int)L; { const int q = nwg / NXCD, r = nwg % NXCD, xcd = wgid % NXCD, off = wgid / NXCD; wgid = (xcd < r ? xcd * (q + 1) : r * (q + 1) + (xcd - r) * q) + off; }
        const int nig = WGM * nN, gid = wgid / nig, fm = gid * WGM, gsz = (nM - fm) < WGM ? (nM - fm) : WGM;
        u.pm = fm + ((wgid % nig) % gsz); u.pn = (wgid % nig) / gsz; return true;
    }
};
struct EpiBf16 {
    static constexpr bool PERM = true;
    bf16_t* O; int ldc;
    __device__ __forceinline__ void operator()(const f32x4 (&acc)[2][2][4][2], const Unit& u, int wr, int wc, int fr, int fq) const {
        const int row0 = u.pm * BM + wr * 64 + fr; const int col0 = u.pn * BM + wc * 32 + 8 * fq;
#pragma unroll
        for (int ai = 0; ai < 2; ++ai)
#pragma unroll
            for (int m = 0; m < 4; ++m) { bf16_t* rowp = O + (size_t)(row0 + ai * HALF + m * 16) * ldc + col0;
#pragma unroll
                for (int bj = 0; bj < 2; ++bj) { const f32x4 v0 = acc[ai][bj][m][0], v1 = acc[ai][bj][m][1];
                    u32x4 w; w.x = pk2(v0[0], v0[1]); w.y = pk2(v0[2], v0[3]); w.z = pk2(v1[0], v1[1]); w.w = pk2(v1[2], v1[3]);
                    *(u32x4*)(rowp + bj * HALF) = w; } }
    }
};
struct EpiIn0 {
    static constexpr bool PERM = true;
    bf16_t* O; int ldc; float* outv;
    __device__ __forceinline__ void operator()(const f32x4 (&acc)[2][2][4][2], const Unit& u, int wr, int wc, int fr, int fq) const {
        const int row0 = u.pm * BM + wr * 64 + fr; const int col0 = u.pn * BM + wc * 32 + 8 * fq;
        const bool do_out = u.pm < 32 && u.pn == 17;
#pragma unroll
        for (int ai = 0; ai < 2; ++ai)
#pragma unroll
            for (int m = 0; m < 4; ++m) { const int row = row0 + ai * HALF + m * 16; bf16_t* rowp = O + (size_t)row * ldc + col0;
#pragma unroll
                for (int bj = 0; bj < 2; ++bj) { const f32x4 v0 = acc[ai][bj][m][0], v1 = acc[ai][bj][m][1];
                    u32x4 w; w.x = pk2(v0[0], v0[1]); w.y = pk2(v0[2], v0[3]); w.z = pk2(v1[0], v1[1]); w.w = pk2(v1[2], v1[3]);
                    *(u32x4*)(rowp + bj * HALF) = w;
                    if (do_out) { float* o = outv + (size_t)row * 256 + (col0 - 4352) + bj * HALF; *(f32x4*)o = v0; *(f32x4*)(o + 4) = v1; } } }
    }
};
struct EpiIn1 {
    static constexpr bool PERM = true;
    bf16_t* O; int ldc; float* outk; float* outv; const f32x2* rope;
    __device__ __forceinline__ void operator()(const f32x4 (&acc)[2][2][4][2], const Unit& u, int wr, int wc, int fr, int fq) const {
        const int row0 = u.pm * BM + wr * 64 + fr; const int col0 = u.pn * BM + wc * 32 + 8 * fq;
        const bool sample = u.pm >= 32, do_rope = sample && u.pn < 16, do_out = !sample && u.pn >= 8 && u.pn < 24;
        const bool hi = fq >= 2;
        float* outp = u.pn < 16 ? outk + (col0 - 2048) : outv + (col0 - 4096);
#pragma unroll
        for (int ai = 0; ai < 2; ++ai)
#pragma unroll
            for (int m = 0; m < 4; ++m) { const int row = row0 + ai * HALF + m * 16;
                f32x4 cs[4];
                if (do_rope) { const int t = (row - NPROMPT) & 4095; const int pos = (wc & 1) ? (t & 63) : (t >> 6);
                    const f32x4* rp = (const f32x4*)(rope + pos * 16 + 8 * (fq & 1));
#pragma unroll
                    for (int q = 0; q < 4; ++q) cs[q] = rp[q]; }
                bf16_t* rowp = O + (size_t)row * ldc + col0;
#pragma unroll
                for (int bj = 0; bj < 2; ++bj) { f32x4 v0 = acc[ai][bj][m][0], v1 = acc[ai][bj][m][1];
                    if (u.pn < 8) { v0 *= 0.125f * 1.4426950408889634f; v1 *= 0.125f * 1.4426950408889634f; }
                    if (do_rope) {
#pragma unroll
                        for (int e = 0; e < 8; ++e) { const float x = e < 4 ? v0[e & 3] : v1[e & 3];
                            const auto rr = __builtin_amdgcn_permlane32_swap(__float_as_uint(x), __float_as_uint(x), false, false);
                            const float pf = __uint_as_float(hi ? rr[0] : rr[1]);
                            const float c = cs[e >> 1][(e & 1) * 2], s = cs[e >> 1][(e & 1) * 2 + 1];
                            const float y = hi ? pf * s + x * c : x * c - pf * s;
                            if (e < 4) v0[e & 3] = y; else v1[e & 3] = y; }
                    }
                    u32x4 w; w.x = pk2(v0[0], v0[1]); w.y = pk2(v0[2], v0[3]); w.z = pk2(v1[0], v1[1]); w.w = pk2(v1[2], v1[3]);
                    *(u32x4*)(rowp + bj * HALF) = w;
                    if (do_out) { float* o = outp + (size_t)row * 2048 + bj * HALF; *(f32x4*)o = v0; *(f32x4*)(o + 4) = v1; }
                } }
    }
};
struct EpiResid {
    static constexpr bool PERM = false;
    const float* xa; const float* xb; float* xout; const float* gate;
    __device__ __forceinline__ void operator()(const f32x4 (&acc)[2][2][4][2], const Unit& u, int wr, int wc, int fr, int fq) const {
        const int row0 = u.pm * BM + wr * 64 + fr, col0 = u.pn * BM + wc * 32 + 4 * fq;
        const int ci = u.pm < 32 ? 0 : 1 + ((u.pm - 32) >> 4);
        const float* gp = gate + ci * 6144 + col0;
        f32x4 gv[2][2];
#pragma unroll
        for (int bj = 0; bj < 2; ++bj)
#pragma unroll
            for (int n = 0; n < 2; ++n) gv[bj][n] = *(const f32x4*)(gp + bj * HALF + n * 16);
#pragma unroll
        for (int ai = 0; ai < 2; ++ai)
#pragma unroll
            for (int m = 0; m < 4; ++m) { const int row = row0 + ai * HALF + m * 16;
                const float* xr = (row < NPROMPT ? xa + (size_t)row * DM : xb + (size_t)(row - NPROMPT) * DM) + col0;
                float* orow = xout + (size_t)row * DM + col0;
#pragma unroll
                for (int bj = 0; bj < 2; ++bj)
#pragma unroll
                    for (int n = 0; n < 2; ++n) { const f32x4 xv = *(const f32x4*)(xr + bj * HALF + n * 16);
                        *(f32x4*)(orow + bj * HALF + n * 16) = xv + gv[bj][n] * acc[ai][bj][m][n]; } }
    }
};

template <class Epi, class Sched>
__device__ __forceinline__ void gemm_phase(LAS unsigned char* lds, const Gemm g, const Sched& S, const Epi& E) {
    const int tid = threadIdx.x, wid = __builtin_amdgcn_readfirstlane(tid >> 6), lane = tid & 63, wr = wid >> 2, wc = wid & 3, fr = lane & 15, fq = lane >> 4;
    const int K = g.K, nt = K / BK;
    unsigned voffA[2], voffB[2];
#pragma unroll
    for (int i = 0; i < 2; ++i) { int R, C; stage_rc(tid * 16 + i * 8192, R, C); const int Rb = Epi::PERM ? ((R & ~31) + perm32(R & 31)) : R;
        voffA[i] = (unsigned)(R * K + C) * 2u; voffB[i] = (unsigned)(Rb * K + C) * 2u; }
    const size_t kstep = (size_t)(BK * 2);
    const size_t hstep = (size_t)HALF * K * 2;
    const size_t tstep = 2 * hstep;
    const unsigned ldsw = (unsigned)wid * 1024u;
    const int aoff = lds_byte(wr * 64 + fr, fq * 8), boff = lds_byte(wc * 32 + fr, fq * 8);
#define PG8_SA(b, h) (((b) * 2 + (h)) * HTB)
#define PG8_SB(b, h) ((4 + (b) * 2 + (h)) * HTB)
#define PG8_STAGE(bufoff, gbase, voff) do { _Pragma("unroll") for (int _i = 0; _i < 2; ++_i) \
        __builtin_amdgcn_global_load_lds((const unsigned*)((const char*)(gbase) + (voff)[_i]), (LAS unsigned*)(lds + (bufoff) + ldsw + _i * 8192), 16, 0, 0); } while (0)
#define PG8_LDA(dst, b, h) do { _Pragma("unroll") for (int m = 0; m < 4; ++m) _Pragma("unroll") for (int k = 0; k < 2; ++k) dst[m][k] = *(const LAS bf16x8*)(lds + PG8_SA(b, h) + aoff + m * 2048 + k * 1024); } while (0)
#define PG8_LDB(dst, b, h) do { _Pragma("unroll") for (int n = 0; n < 2; ++n) _Pragma("unroll") for (int k = 0; k < 2; ++k) dst[n][k] = *(const LAS bf16x8*)(lds + PG8_SB(b, h) + boff + n * 2048 + k * 1024); } while (0)
#define PG8_MMA(ai, bj, At, Bt) do { __builtin_amdgcn_s_setprio(1); _Pragma("unroll") for (int m = 0; m < 4; ++m) _Pragma("unroll") for (int n = 0; n < 2; ++n) _Pragma("unroll") for (int k = 0; k < 2; ++k) \
        acc[ai][bj][m][n] = __builtin_amdgcn_mfma_f32_16x16x32_bf16(Bt[n][k], At[m][k], acc[ai][bj][m][n], 0, 0, 0); __builtin_amdgcn_s_setprio(0); } while (0)
#define PG8_WAIT_V(n) asm volatile("s_waitcnt vmcnt(" #n ")" ::: "memory")
#define PG8_WAIT_L(n) asm volatile("s_waitcnt lgkmcnt(" #n ")" ::: "memory")
#define PG8_BAR __builtin_amdgcn_s_barrier()
#define PG8_SCHED __builtin_amdgcn_sched_barrier(0)
    Unit cur, nxt; int ui = 0;
    if (!S.next(0, cur)) return;
    f32x4 acc[2][2][4][2];
#pragma unroll
    for (int a = 0; a < 2; ++a)
#pragma unroll
        for (int b = 0; b < 2; ++b)
#pragma unroll
            for (int m = 0; m < 4; ++m)
#pragma unroll
                for (int n = 0; n < 2; ++n) acc[a][b][m][n] = (f32x4){0.f, 0.f, 0.f, 0.f};
    bf16x8 At[4][2], B0[2][2], B1[2][2];
    const char* cA = (const char*)g.A + (size_t)cur.pm * tstep; const char* cB = (const char*)g.Bt + (size_t)cur.pn * tstep;
    PG8_STAGE(PG8_SB(0, 0), cB, voffB); PG8_STAGE(PG8_SA(0, 0), cA, voffA); PG8_STAGE(PG8_SB(0, 1), cB + hstep, voffB); PG8_STAGE(PG8_SA(0, 1), cA + hstep, voffA);
    if (wr == 1) PG8_BAR;
    PG8_WAIT_V(4); PG8_BAR;
    PG8_STAGE(PG8_SB(1, 0), cB + kstep, voffB); PG8_STAGE(PG8_SA(1, 0), cA + kstep, voffA); PG8_STAGE(PG8_SB(1, 1), cB + hstep + kstep, voffB);
    PG8_WAIT_V(6); PG8_BAR;
    for (;;) {
        const bool has_next = S.next(ui + 1, nxt);
        const char* nA = has_next ? (const char*)g.A + (size_t)nxt.pm * tstep : cA; const char* nB = has_next ? (const char*)g.Bt + (size_t)nxt.pn * tstep : cB;
        for (int t = 0; t < nt; t += 2) {
            const bool last = (t == nt - 2);
            const char* a1 = cA + (size_t)(t + 1) * kstep;
            const char* a2 = last ? nA : cA + (size_t)(t + 2) * kstep; const char* b2 = last ? nB : cB + (size_t)(t + 2) * kstep;
            const char* a3 = a2 + kstep; const char* b3 = b2 + kstep;
            PG8_LDB(B0, 0, 0); PG8_SCHED; PG8_LDA(At, 0, 0); PG8_STAGE(PG8_SA(1, 1), a1 + hstep, voffA);
            PG8_WAIT_L(8); PG8_BAR; PG8_WAIT_L(0); PG8_MMA(0, 0, At, B0); PG8_BAR; PG8_SCHED;
            PG8_LDB(B1, 0, 1); PG8_STAGE(PG8_SB(0, 0), b2, voffB);
            PG8_BAR; PG8_WAIT_L(0); PG8_MMA(0, 1, At, B1); PG8_BAR;
            PG8_LDA(At, 0, 1); PG8_STAGE(PG8_SA(0, 0), a2, voffA);
            PG8_BAR; PG8_WAIT_L(0); PG8_MMA(1, 0, At, B0); PG8_BAR; PG8_SCHED;
            PG8_STAGE(PG8_SB(0, 1), b2 + hstep, voffB);
            PG8_WAIT_V(6); PG8_BAR; PG8_MMA(1, 1, At, B1); PG8_BAR;
            PG8_LDB(B0, 1, 0); PG8_SCHED; PG8_LDA(At, 1, 0); PG8_STAGE(PG8_SA(0, 1), a2 + hstep, voffA);
            PG8_WAIT_L(8); PG8_BAR; PG8_WAIT_L(0); PG8_MMA(0, 0, At, B0); PG8_BAR; PG8_SCHED;
            PG8_LDB(B1, 1, 1); PG8_STAGE(PG8_SB(1, 0), b3, voffB);
            PG8_BAR; PG8_WAIT_L(0); PG8_MMA(0, 1, At, B1); PG8_BAR;
            PG8_LDA(At, 1, 1); PG8_STAGE(PG8_SA(1, 0), a3, voffA);
            PG8_BAR; PG8_WAIT_L(0); PG8_MMA(1, 0, At, B0); PG8_BAR; PG8_SCHED;
            PG8_STAGE(PG8_SB(1, 1), b3 + hstep, voffB);
            PG8_WAIT_V(6); PG8_BAR; PG8_MMA(1, 1, At, B1); PG8_BAR;
        }
        E(acc, cur, wr, wc, fr, fq);
        if (!has_next) break;
#pragma unroll
        for (int a = 0; a < 2; ++a)
#pragma unroll
            for (int b = 0; b < 2; ++b)
#pragma unroll
                for (int m = 0; m < 4; ++m)
#pragma unroll
                    for (int n = 0; n < 2; ++n) acc[a][b][m][n] = (f32x4){0.f, 0.f, 0.f, 0.f};
        cur = nxt; cA = nA; cB = nB; ++ui;
    }
    PG8_WAIT_V(0);
    if (wr == 0) PG8_BAR;
    PG8_BAR;
#undef PG8_SA
#undef PG8_SB
#undef PG8_STAGE
#undef PG8_LDA
#undef PG8_LDB
#undef PG8_MMA
#undef PG8_WAIT_V
#undef PG8_WAIT_L
#undef PG8_BAR
#undef PG8_SCHED
}
}

__device__ __forceinline__ void transpose_item(const float* W, int K, int N, u16* WT, LAS float* scr, int item, int lane) {
    const int nblk = N / 32, kb = item / nblk, nb = item % nblk, k0 = 64 * kb, n0 = 32 * nb;
#pragma unroll 8
    for (int i = 0; i < 32; ++i) { const int kk = 2 * i + (lane >> 5); scr[kk * 33 + (lane & 31)] = W[(size_t)(k0 + kk) * N + n0 + (lane & 31)]; }
    asm volatile("s_waitcnt lgkmcnt(0)" ::: "memory");
    const int c = lane & 7;
#pragma unroll
    for (int j = 0; j < 4; ++j) { const int n = (lane >> 3) + 8 * j; const LAS float* s = scr + (8 * c) * 33 + n;
        u32x4 o; o.x = pk2(s[0 * 33], s[1 * 33]); o.y = pk2(s[2 * 33], s[3 * 33]); o.z = pk2(s[4 * 33], s[5 * 33]); o.w = pk2(s[6 * 33], s[7 * 33]);
        *(u32x4*)(WT + (size_t)(n0 + n) * K + k0 + 8 * c) = o; }
    asm volatile("s_waitcnt lgkmcnt(0)" ::: "memory");
}
__device__ __forceinline__ void cvt_copy(const float* src, u16* dst, int n4, int gtid, int gsz) {
    for (int i = gtid; i < n4; i += gsz) { const f32x4 v = ((const f32x4*)src)[i]; u32x2 w; w.x = pk2(v[0], v[1]); w.y = pk2(v[2], v[3]); ((u32x2*)dst)[i] = w; }
}
__device__ __forceinline__ void phase_prep(const Params& p, LAS unsigned char* lds) {
    const int tid = threadIdx.x, lane = tid & 63, wave = tid >> 6;
    float* mod = (float*)(p.ws + WS_MOD);
    for (int it = blockIdx.x; it < 192; it += gridDim.x) {
        const int l = it / 96, col0 = (it % 96) * 64;
        const float* W = p.in[l ? 17 : 8]; const float* bias = p.in[l ? 18 : 9];
        LAS float* sc = (LAS float*)lds; LAS float* red = sc + 3 * 2048;
        for (int i = tid; i < 3 * 2048; i += 512) { const int ci = i >> 11, k = i & 2047; const float v = ci == 0 ? p.in[7][k] : p.in[6][(ci - 1) * 2048 + k]; sc[i] = v / (1.f + expf(-v)); }
        __syncthreads();
        const int c4 = tid & 15, kq = tid >> 4;
        f32x4 a0 = {0.f, 0.f, 0.f, 0.f}, a1 = a0, a2 = a0;
        const float* wp = W + (size_t)(kq * 64) * 6144 + col0 + c4 * 4;
#pragma unroll 16
        for (int k = 0; k < 64; ++k) { const f32x4 w = *(const f32x4*)(wp + (size_t)k * 6144); const int kk = kq * 64 + k; a0 += w * sc[kk]; a1 += w * sc[2048 + kk]; a2 += w * sc[4096 + kk]; }
        LAS f32x4* red4 = (LAS f32x4*)red;
        red4[(kq * 3 + 0) * 16 + c4] = a0; red4[(kq * 3 + 1) * 16 + c4] = a1; red4[(kq * 3 + 2) * 16 + c4] = a2;
        __syncthreads();
        if (tid < 192) { const int ci = tid >> 6, c = tid & 63; float s = bias[col0 + c];
#pragma unroll 8
            for (int q = 0; q < 32; ++q) s += red[((q * 3 + ci) * 16 + (c >> 2)) * 4 + (c & 3)];
            mod[(l * 3 + ci) * 6144 + col0 + c] = s; }
        __syncthreads();
    }
    {
        LAS float* scr = (LAS float*)(lds + wave * 8448);
        const int gw = blockIdx.x * 8 + wave, NGW = gridDim.x * 8;
        constexpr int I0 = 32 * (IN0 / 32), I1 = 32 * (DM / 32);
        for (int it = gw; it < I0 + I1; it += NGW) {
            if (it < I0) transpose_item(p.in[11], DM, IN0, (u16*)(p.ws + WS_WIN0), scr, it, lane);
            else transpose_item(p.in[16], DM, DM, (u16*)(p.ws + WS_WOUT0), scr, it - I0, lane);
        }
    }
    {
        const int gtid = blockIdx.x * 512 + tid, gsz = gridDim.x * 512;
        cvt_copy(p.in[2], (u16*)(p.ws + WS_CK0), 131072 / 4, gtid, gsz);
        cvt_copy(p.in[3], (u16*)(p.ws + WS_CV0), 131072 / 4, gtid, gsz);
        for (int i = gtid; i < 1048576 / 4; i += gsz) { const int r = i >> 9, c4 = i & 511;
            const f32x4 a = ((const f32x4*)p.in[4])[i], b = ((const f32x4*)p.in[5])[i]; u32x2 wa, wb; wa.x = pk2(a[0], a[1]); wa.y = pk2(a[2], a[3]); wb.x = pk2(b[0], b[1]); wb.y = pk2(b[2], b[3]);
            *(u32x2*)((u16*)(p.ws + WS_CK1) + (size_t)r * LDC1 + c4 * 4) = wa; *(u32x2*)((u16*)(p.ws + WS_CV1) + (size_t)r * LDC1 + c4 * 4) = wb; }
        f32x2* r0 = (f32x2*)(p.ws + WS_ROPE0); f32x2* r1 = (f32x2*)(p.ws + WS_ROPE1);
        for (int i = gtid; i < 64 * 32 + 64 * 16; i += gsz) {
            int pos, idx; float fr;
            if (i < 2048) { pos = i >> 5; idx = i & 31; fr = exp2f(-(float)idx * (13.287712379549449f / 32.f)); }
            else { const int j = i - 2048; pos = j >> 4; idx = j & 15; fr = exp2f(-(float)idx * (13.287712379549449f / 16.f)); }
            float t = (float)pos * fr * 0.15915494309189535f; t -= floorf(t);
            f32x2 cs; cs.x = __builtin_amdgcn_cosf(t); cs.y = __builtin_amdgcn_sinf(t);
            if (i < 2048) r0[i] = cs; else r1[i - 2048] = cs;
        }
    }
}

__device__ __forceinline__ void prep_w1(const Params& p, LAS unsigned char* lds, int part, int nparts) {
    const int tid = threadIdx.x, lane = tid & 63, wave = tid >> 6;
    LAS float* scr = (LAS float*)(lds + wave * 8448);
    constexpr int I2 = 32 * (IN1 / 32), I3 = 32 * (DM / 32);
    for (int it = part * 8 + wave; it < I2 + I3; it += nparts * 8) {
        if (it < I2) transpose_item(p.in[20], DM, IN1, (u16*)(p.ws + WS_WIN1), scr, it, lane);
        else transpose_item(p.in[26], DM, DM, (u16*)(p.ws + WS_WOUT1), scr, it - I2, lane);
    }
}

template <int MODE, bool RES>
__device__ __forceinline__ void phase_norm(const Params& p, int layer, LAS unsigned char* lds) {
    const int tid = threadIdx.x, lane = tid & 63, wave = tid >> 6;
    const int gw = blockIdx.x * 8 + wave, NGW = gridDim.x * 8;
    const float* mod = (const float*)(p.ws + WS_MOD);
    const float* gam = p.in[MODE == 1 ? 27 : (layer ? 19 : 10)];
    u16* hbuf = (u16*)(p.ws + WS_A);
    const u16* outb = (const u16*)(p.ws + WS_Z);
    const int res_layer = MODE == 1 ? 1 : 0;
    const bool x_from_input = (MODE == 0) && (layer == 0 || RES);
    LAS f32x4* Tg = (LAS f32x4*)lds; LAS f32x4* Tm = (LAS f32x4*)(lds + 24576); LAS f32x4* Ts = (LAS f32x4*)(lds + 32768); LAS f32x4* Tb = (LAS f32x4*)(lds + 57344);
    for (int i = tid; i < 3 * 512; i += 512) { const int ci = i >> 9, c = i & 511;
        if (RES) Tg[i] = ((const f32x4*)(mod + (res_layer * 3 + ci) * 6144 + 4096))[c];
        if (MODE == 0) { Tb[i] = ((const f32x4*)(mod + (layer * 3 + ci) * 6144))[c]; Ts[i] = ((const f32x4*)(mod + (layer * 3 + ci) * 6144 + 2048))[c]; } }
    for (int i = tid; i < 512; i += 512) Tm[i] = ((const f32x4*)gam)[i];
    __syncthreads();
    f32x4 xa[8], xb[8]; u32x2 oa[8], ob[8];
#define NORM_LOAD(XV, OV, row_) do { const int r_ = (row_); \
        if (x_from_input) { const float* xr_ = r_ < NPROMPT ? p.in[0] + (size_t)r_ * DM : p.in[1] + (size_t)(r_ - NPROMPT) * DM; \
            _Pragma("unroll") for (int j = 0; j < 8; ++j) XV[j] = ((const f32x4*)xr_)[lane + 64 * j]; } \
        else { const u32x2* xb_ = (const u32x2*)(p.out + OUT_Y + (size_t)r_ * DM); \
            _Pragma("unroll") for (int j = 0; j < 8; ++j) { const u32x2 w_ = xb_[lane + 64 * j]; XV[j] = (f32x4){bflo(w_.x), bfhi(w_.x), bflo(w_.y), bfhi(w_.y)}; } } \
        if (RES) { const u32x2* or_ = (const u32x2*)(outb + (size_t)r_ * DM); _Pragma("unroll") for (int j = 0; j < 8; ++j) OV[j] = or_[lane + 64 * j]; } } while (0)
    int row = gw;
    if (row < NTOK) NORM_LOAD(xa, oa, row);
    while (row < NTOK) {
        const int nrow = row + NGW;
        if (nrow < NTOK) NORM_LOAD(xb, ob, nrow);
        const int ci = cond_of_row(row);
        float ss = 0.f;
#pragma unroll
        for (int j = 0; j < 8; ++j) {
            if (RES) { const f32x4 g = Tg[ci * 512 + lane + 64 * j];
                xa[j][0] += g[0] * bflo(oa[j].x); xa[j][1] += g[1] * bfhi(oa[j].x); xa[j][2] += g[2] * bflo(oa[j].y); xa[j][3] += g[3] * bfhi(oa[j].y); }
            ss += xa[j][0] * xa[j][0] + xa[j][1] * xa[j][1] + xa[j][2] * xa[j][2] + xa[j][3] * xa[j][3]; }
        ss = wave_sum(ss);
        const float rstd = 1.0f / sqrtf(ss * (1.f / DM) + EPS);
        if (MODE == 0) {
            if (RES) { u32x2* xo = (u32x2*)(p.out + OUT_Y + (size_t)row * DM);
#pragma unroll
                for (int j = 0; j < 8; ++j) { u32x2 w; w.x = pk2(xa[j][0], xa[j][1]); w.y = pk2(xa[j][2], xa[j][3]); xo[lane + 64 * j] = w; } }
#pragma unroll
            for (int j = 0; j < 8; ++j) { const int idx = lane + 64 * j; const f32x4 hh = xa[j] * rstd * Tm[idx] * (Ts[ci * 512 + idx] + 1.f) + Tb[ci * 512 + idx];
                u32x2 w; w.x = pk2(hh[0], hh[1]); w.y = pk2(hh[2], hh[3]);
                ((u32x2*)(hbuf + (size_t)row * DM))[idx] = w; }
        } else {
            float* yr = p.out + OUT_Y + (size_t)row * DM;
#pragma unroll
            for (int j = 0; j < 8; ++j) ((f32x4*)yr)[lane + 64 * j] = xa[j] * rstd * Tm[lane + 64 * j];
        }
#pragma unroll
        for (int j = 0; j < 8; ++j) { xa[j] = xb[j]; oa[j] = ob[j]; }
        row = nrow;
    }
#undef NORM_LOAD
}

__device__ __forceinline__ void phase_post0(const Params& p) {
    const int tid = threadIdx.x, lane = tid & 63, wave = tid >> 6;
    const int gw = blockIdx.x * 8 + wave, NGW = gridDim.x * 8;
    u16* z = (u16*)(p.ws + WS_Z);
    const f32x2* rope = (const f32x2*)(p.ws + WS_ROPE0);
    const float* kg = p.in[15];
    const int sub = lane >> 5, cc = lane & 31, head = cc >> 4, c = cc & 15, d0 = c * 8;
    for (int r2 = gw; r2 < NTOK / 2; r2 += NGW) {
        const int row = r2 * 2 + sub;
        u16* zr = z + (size_t)row * LD0 + Z0_K + cc * 8;
        const bool sample = row >= NPROMPT; const int t = (row - NPROMPT) & 4095; const int prow = t >> 6, pcol = t & 63;
        const u32x4 w = *(const u32x4*)zr;
        float f[8]; unpack8(w, f);
        float ss = 0.f;
#pragma unroll
        for (int e = 0; e < 8; ++e) ss += f[e] * f[e];
        ss += __shfl_xor(ss, 1); ss += __shfl_xor(ss, 2); ss += __shfl_xor(ss, 4); ss += __shfl_xor(ss, 8);
        const float rstd = 1.0f / sqrtf(ss * (1.f / 128.f) + EPS);
#pragma unroll
        for (int e = 0; e < 8; ++e) f[e] = f[e] * rstd * kg[d0 + e];
        if (!sample) { float* o = p.out + OUT_K0 + (size_t)row * 256 + head * 128 + d0;
            *(f32x4*)o = (f32x4){f[0], f[1], f[2], f[3]}; *(f32x4*)(o + 4) = (f32x4){f[4], f[5], f[6], f[7]}; }
        if (sample) { const bool first = (c & 4) == 0; const int pos = c < 8 ? prow : pcol; const int i0 = (c & 3) * 8;
#pragma unroll
            for (int e = 0; e < 8; ++e) { const float pf = __shfl_xor(f[e], 4); const f32x2 cs = rope[pos * 32 + i0 + e];
                f[e] = first ? f[e] * cs.x - pf * cs.y : pf * cs.y + f[e] * cs.x; } }
        *(u32x4*)zr = pack8(f);
    }
}
__device__ __forceinline__ void phase_post1(const Params& p) {
    const int tid = threadIdx.x, lane = tid & 63, wave = tid >> 6;
    const int gw = blockIdx.x * 8 + wave, NGW = gridDim.x * 8;
    u16* z = (u16*)(p.ws + WS_Z);
    const f32x2* rope = (const f32x2*)(p.ws + WS_ROPE1);
    for (int row = gw; row < NTOK; row += NGW) {
        u16* zr = z + (size_t)row * LD1;
        if (row < NPROMPT) {
#pragma unroll
            for (int i = 0; i < 8; ++i) { const int cidx = lane + 64 * i;
                const u32x4 w = *(const u32x4*)(zr + Z1_K + cidx * 8); float f[8]; unpack8(w, f);
                float* o = p.out + (cidx < 256 ? OUT_K1 + (size_t)row * 2048 + cidx * 8 : OUT_V1 + (size_t)row * 2048 + (cidx - 256) * 8);
                *(f32x4*)o = (f32x4){f[0], f[1], f[2], f[3]}; *(f32x4*)(o + 4) = (f32x4){f[4], f[5], f[6], f[7]}; }
        } else {
            const int t = (row - NPROMPT) & 4095; const int prow = t >> 6, pcol = t & 63;
#pragma unroll
            for (int i = 0; i < 8; ++i) { const int cidx = lane + 64 * i; const int c = cidx & 7;
                const u32x4 w = *(const u32x4*)(zr + Z1_Q + cidx * 8); float f[8]; unpack8(w, f);
                const bool first = (c & 2) == 0; const int pos = c < 4 ? prow : pcol; const int i0 = (c & 1) * 8;
#pragma unroll
                for (int e = 0; e < 8; ++e) { const float pf = __shfl_xor(f[e], 2); const f32x2 cs = rope[pos * 16 + i0 + e];
                    f[e] = first ? f[e] * cs.x - pf * cs.y : pf * cs.y + f[e] * cs.x; }
                *(u32x4*)(zr + Z1_Q + cidx * 8) = pack8(f); }
        }
    }
}

#define SBAR() do {} while (0)
template <int DQK>
__device__ __forceinline__ void attn_qk32(LAS unsigned char* Kt, const bf16x8 (&qf)[DQK / 16], unsigned kbase, unsigned xr, int kch0, int h, f32x16& s) {
#pragma unroll
    for (int r = 0; r < 16; ++r) s[r] = 0.f;
#pragma unroll
    for (int ks = 0; ks < DQK / 16; ++ks) {
        const unsigned ko = kbase + 16u * (((unsigned)(kch0 + 2 * ks + h)) ^ xr);
        const bf16x8 a = *(const LAS bf16x8*)(Kt + ko);
        s = MFMA32(a, qf[ks], s);
        if (DQK == 128 && ks == 3) SBAR();
    }
}
__device__ __forceinline__ void attn_partial_sm(f32x16& S, float sc, float& m_run, float& alpha, int& resc) {
    float mx = S[0];
#pragma unroll
    for (int r = 1; r < 16; ++r) mx = fmaxf(mx, S[r]);
    { const auto rr = __builtin_amdgcn_permlane32_swap(__float_as_uint(mx), __float_as_uint(mx), false, false);
      mx = fmaxf(__uint_as_float(rr[0]), __uint_as_float(rr[1])); }
    resc = __any((mx - m_run) * sc > 11.5f);
    const float mn = resc ? fmaxf(m_run, mx) : m_run;
    alpha = resc ? __builtin_amdgcn_exp2f((m_run - mn) * sc) : 1.f;
    m_run = mn;
    const float ms = -mn * sc;
#pragma unroll
    for (int r = 0; r < 16; ++r) S[r] = fmaf(S[r], sc, ms);
#pragma unroll
    for (int r = 0; r < 8; ++r) S[r] = __builtin_amdgcn_exp2f(S[r]);
}
__device__ __forceinline__ void attn_finish_sm(f32x16& S, float alpha, float& l_run, bf16x8 (&pb)[2]) {
#pragma unroll
    for (int r = 8; r < 16; ++r) S[r] = __builtin_amdgcn_exp2f(S[r]);
    float rs = 0.f;
#pragma unroll
    for (int r = 0; r < 16; ++r) rs += S[r];
    l_run = l_run * alpha + rs;
#pragma unroll
    for (int s = 0; s < 2; ++s) { u32x4 pw; const int r0 = s * 8;
        pw.x = pk2(S[r0], S[r0 + 1]); pw.y = pk2(S[r0 + 2], S[r0 + 3]); pw.z = pk2(S[r0 + 4], S[r0 + 5]); pw.w = pk2(S[r0 + 6], S[r0 + 7]); pb[s] = __builtin_bit_cast(bf16x8, pw); }
}
__device__ __forceinline__ void attn_pv2(LAS unsigned char* Vt, const unsigned (&vaddr)[2][4], const bf16x8 (&pb)[2], f32x16 (&O)[4]) {
#pragma unroll
    for (int dt = 0; dt < 4; ++dt)
#pragma unroll
        for (int s = 0; s < 2; ++s) {
            const bf16x8 va = tr_pair(Vt + s * 4096 + vaddr[0][dt], Vt + s * 4096 + vaddr[1][dt]);
            O[dt] = MFMA32(va, pb[s], O[dt]);
        }
}
__device__ __forceinline__ void attn_resc(f32x16 (&O)[4], float alpha, int resc) {
    if (resc) {
#pragma unroll
        for (int dt = 0; dt < 4; ++dt) O[dt] *= alpha;
    }
}
__device__ __forceinline__ bf16x8 ones_frag() { u32x4 w; w.x = w.y = w.z = w.w = 0x3F803F80u; return __builtin_bit_cast(bf16x8, w); }
template <int DQK>
__device__ __forceinline__ void attn_qk32_aug(LAS unsigned char* Kt, const bf16x8 (&qf)[DQK / 16], const bf16x8 qaug, unsigned kbase, unsigned xr, int kch0, int h, f32x16& s) {
#pragma unroll
    for (int r = 0; r < 16; ++r) s[r] = 0.f;
    s = MFMA32(ones_frag(), qaug, s);
#pragma unroll
    for (int ks = 0; ks < DQK / 16; ++ks) {
        const unsigned ko = kbase + 16u * (((unsigned)(kch0 + 2 * ks + h)) ^ xr);
        const bf16x8 a = *(const LAS bf16x8*)(Kt + ko);
        s = MFMA32(a, qf[ks], s);
    }
}
__device__ __forceinline__ void attn_partial_sm_aug(f32x16& S, float& m_run, bf16x8& qaug, float& alpha, int& resc, bool force, int h) {
    float mx;
    if (force) {
        mx = S[0];
#pragma unroll
        for (int r = 1; r < 16; ++r) mx = fmaxf(mx, S[r]);
        const auto rr = __builtin_amdgcn_permlane32_swap(__float_as_uint(mx), __float_as_uint(mx), false, false);
        mx = fmaxf(__uint_as_float(rr[0]), __uint_as_float(rr[1]));
        resc = 1;
    } else {
        int mi = __float_as_int(S[0]);
#pragma unroll
        for (int r = 1; r < 16; ++r) mi = max(mi, __float_as_int(S[r]));
        const auto rr = __builtin_amdgcn_permlane32_swap((unsigned)mi, (unsigned)mi, false, false);
        mi = max((int)rr[0], (int)rr[1]);
        mx = __int_as_float(mi);
        resc = __any(mx > 11.5f);
    }
    alpha = 1.f;
    if (__builtin_expect(resc, 0)) {
        asm volatile("" ::: "memory");
        const float d = force ? mx : fmaxf(mx, 0.f);
        const unsigned mb = pk2(m_run + d, 0.f) & 0xffffu;
        const float m_new = __uint_as_float(mb << 16), dd = m_new - m_run;
        alpha = __builtin_amdgcn_exp2f(-dd); m_run = m_new;
#pragma unroll
        for (int r = 0; r < 16; ++r) S[r] -= dd;
        u32x4 qa; qa.x = h == 0 ? (mb ^ 0x8000u) : 0u; qa.y = 0u; qa.z = 0u; qa.w = 0u; qaug = __builtin_bit_cast(bf16x8, qa);
    }
#pragma unroll
    for (int r = 0; r < 8; ++r) S[r] = __builtin_amdgcn_exp2f(S[r]);
}
__device__ __forceinline__ void attn_finish_sm_aug(f32x16& S, bf16x8 (&pb)[2]) {
#pragma unroll
    for (int r = 8; r < 16; ++r) S[r] = __builtin_amdgcn_exp2f(S[r]);
#pragma unroll
    for (int s = 0; s < 2; ++s) { u32x4 pw; const int r0 = s * 8;
        pw.x = pk2(S[r0], S[r0 + 1]); pw.y = pk2(S[r0 + 2], S[r0 + 3]); pw.z = pk2(S[r0 + 4], S[r0 + 5]); pw.w = pk2(S[r0 + 6], S[r0 + 7]); pb[s] = __builtin_bit_cast(bf16x8, pw); }
}
__device__ __forceinline__ void attn_pv2_aug(LAS unsigned char* Vt, const unsigned (&vaddr)[2][4], const bf16x8 (&pb)[2], f32x16 (&O)[4], f32x16& O5) {
    __builtin_amdgcn_s_setprio(1);
#pragma unroll
    for (int dt = 0; dt < 4; ++dt)
#pragma unroll
        for (int s = 0; s < 2; ++s) {
            const bf16x8 va = tr_pair(Vt + s * 4096 + vaddr[0][dt], Vt + s * 4096 + vaddr[1][dt]);
            O[dt] = MFMA32(va, pb[s], O[dt]);
        }
    O5 = MFMA32(ones_frag(), pb[0], O5); O5 = MFMA32(ones_frag(), pb[1], O5);
    __builtin_amdgcn_s_setprio(0);
}
__device__ __forceinline__ void attn_resc_aug(f32x16 (&O)[4], f32x16& O5, float alpha, int resc) {
    if (resc) {
#pragma unroll
        for (int dt = 0; dt < 4; ++dt) O[dt] *= alpha;
        O5 *= alpha;
    }
}
template <int DQK, bool AUG>
__device__ __forceinline__ void attn_core(LAS unsigned char* lds, const bf16x8 (&qf)[DQK / 16],
                                          const u16* kown, const u16* vown, int ldo, int n_own,
                                          const u16* kc, const u16* vc, int ldc, int n_cache, int kch0, float sc,
                                          f32x16 (&O)[4], float& m_run, float& l_run) {
    const int tid = threadIdx.x, lane = tid & 63, wave = __builtin_amdgcn_readfirstlane(tid >> 6), h = lane >> 5, l31 = lane & 31;
    const int ntiles = n_own + n_cache;
    unsigned go_own[2], go_c[2];
#pragma unroll
    for (int i = 0; i < 2; ++i) { const unsigned row = 8u * wave + 4u * i + (lane >> 4); const unsigned ch = (lane & 15u) ^ ((((unsigned)lane >> 4) << 2) | ((2u * wave + i) & 3u));
        go_own[i] = row * (unsigned)ldo + ch * 8u; go_c[i] = row * (unsigned)ldc + ch * 8u; }
    const unsigned ldsw = 2048u * wave;
#define ATT_STAGE(own, cch, t, bufoff) do { const bool o_ = (t) < n_own; \
        const u16* b_ = o_ ? (own) + (size_t)(t) * 64 * ldo : (cch) + (size_t)((t) - n_own) * 64 * ldc; \
        const unsigned g0_ = o_ ? go_own[0] : go_c[0], g1_ = o_ ? go_own[1] : go_c[1]; \
        dma16(b_ + g0_, lds + (bufoff) + ldsw); dma16(b_ + g1_, lds + (bufoff) + ldsw + 1024); } while (0)
#define ATT_SYNC() do { asm volatile("s_waitcnt vmcnt(0)" ::: "memory"); __syncthreads(); } while (0)
    const unsigned xr = ((l31 & 3u) << 2) | ((l31 >> 2) & 3u), kbase = 256u * l31;
    const unsigned blk = (lane >> 4) & 1, q4 = (lane & 15) >> 2, p2 = lane & 3;
    unsigned vaddr[2][4];
#pragma unroll
    for (int t = 0; t < 2; ++t)
#pragma unroll
        for (int dt = 0; dt < 4; ++dt) vaddr[t][dt] = off_b(8 * t + 4 * h + q4, 4 * dt + 2 * blk + (p2 >> 1)) + 8 * (p2 & 1);
    int kcur = 0, knext = 16384, kfree = 32768, vcur = 49152, vnext = 65536;
    ATT_STAGE(kown, kc, 0, kcur); ATT_STAGE(vown, vc, 0, vcur); ATT_STAGE(kown, kc, 1, knext);
    ATT_SYNC();
    f32x16 A, B; bf16x8 pb[2]; float alA, alB; int rsA, rsB;
    f32x16 O5; bf16x8 qaug;
#pragma unroll
    for (int r = 0; r < 16; ++r) O5[r] = 0.f;
    { u32x4 zq; zq.x = zq.y = zq.z = zq.w = 0u; qaug = __builtin_bit_cast(bf16x8, zq); }
#define A_QK(Kp, S_) do { if (AUG) attn_qk32_aug<DQK>(Kp, qf, qaug, kbase, xr, kch0, h, S_); else attn_qk32<DQK>(Kp, qf, kbase, xr, kch0, h, S_); } while (0)
#define A_PART(S_, al_, rs_, force_) do { if (AUG) attn_partial_sm_aug(S_, m_run, qaug, al_, rs_, force_, h); else attn_partial_sm(S_, sc, m_run, al_, rs_); } while (0)
#define A_FIN(S_, al_) do { if (AUG) attn_finish_sm_aug(S_, pb); else attn_finish_sm(S_, al_, l_run, pb); } while (0)
#define A_PV(Vp) do { if (AUG) attn_pv2_aug(Vp, vaddr, pb, O, O5); else attn_pv2(Vp, vaddr, pb, O); } while (0)
#define A_RESC(al_, rs_) do { if (AUG) attn_resc_aug(O, O5, al_, rs_); else attn_resc(O, al_, rs_); } while (0)
    A_QK(lds + kcur, A);
    A_PART(A, alA, rsA, true);
    for (int t = 0; t + 1 < ntiles; ++t) {
        ATT_STAGE(vown, vc, t + 1, vnext);
        if (t + 2 < ntiles) ATT_STAGE(kown, kc, t + 2, kfree);
        SBAR(); A_QK(lds + kcur + 8192, B);
        A_FIN(A, alA); SBAR();
        A_PV(lds + vcur); A_PART(B, alB, rsB, false);
        A_RESC(alB, rsB);
        SBAR(); A_QK(lds + knext, A);
        A_FIN(B, alB); SBAR();
        A_PV(lds + vcur + 8192); A_PART(A, alA, rsA, false);
        ATT_SYNC(); A_RESC(alA, rsA);
        { const int tmp = kcur; kcur = knext; knext = kfree; kfree = tmp; const int tv = vcur; vcur = vnext; vnext = tv; }
    }
    SBAR(); A_QK(lds + kcur + 8192, B);
    A_FIN(A, alA); SBAR();
    A_PV(lds + vcur); A_PART(B, alB, rsB, false);
    A_RESC(alB, rsB);
    A_FIN(B, alB); SBAR();
    A_PV(lds + vcur + 8192);
    if (AUG) l_run = O5[0];
    __syncthreads();
#undef A_QK
#undef A_PART
#undef A_FIN
#undef A_PV
#undef A_RESC
#undef ATT_STAGE
#undef ATT_SYNC
}

__device__ __forceinline__ float silu_fast(float v) { return v * __builtin_amdgcn_rcpf(1.f + __builtin_amdgcn_exp2f(-v * LOG2E)); }
template <int NROWS>
__device__ __forceinline__ void attn_gate_store(LAS unsigned char* ybase, const u16* gate0, int ldg, u16* y0) {
    const int tid = threadIdx.x;
#pragma unroll 2
    for (int i = 0; i < NROWS / 32; ++i) { const int n = tid + 512 * i, row = n >> 4, c = n & 15;
        const u32x4 tw = *(const LAS u32x4*)(ybase + (row >> 5) * 8704 + (row & 31) * 272 + c * 16);
        const u32x4 gw = *(const u32x4*)(gate0 + (size_t)row * ldg + c * 8);
        float t[8], g[8]; unpack8(tw, t); unpack8(gw, g);
#pragma unroll
        for (int e = 0; e < 8; ++e) t[e] *= silu_fast(g[e]);
        *(u32x4*)(y0 + (size_t)row * DM + c * 8) = pack8(t); }
}

__device__ __forceinline__ void gqa_item(const Params& p, LAS unsigned char* lds, int qtok0, int hq, int ktok0, int n_own, int cache_b) {
    const int tid = threadIdx.x, lane = tid & 63, wave = tid >> 6, h = lane >> 5, l31 = lane & 31;
    const u16* z = (const u16*)(p.ws + WS_Z);
    const int kvh = hq >> 2;
    const int qtok = qtok0 + wave * 32 + l31;
    bf16x8 qf[8];
    {
        float qv[8][8]; float ss = 0.f;
#pragma unroll
        for (int ks = 0; ks < 8; ++ks) { const u32x4 w = *(const u32x4*)(z + (size_t)qtok * LD0 + Z0_Q + hq * 128 + ks * 16 + h * 8); unpack8(w, qv[ks]);
#pragma unroll
            for (int j = 0; j < 8; ++j) ss += qv[ks][j] * qv[ks][j]; }
        { const auto rr = __builtin_amdgcn_permlane32_swap(__float_as_uint(ss), __float_as_uint(ss), false, false); ss = __uint_as_float(rr[0]) + __uint_as_float(rr[1]); }
        const float rstd = 1.0f / sqrtf(ss * (1.f / 128.f) + EPS);
        const float* qg = p.in[14];
#pragma unroll
        for (int ks = 0; ks < 8; ++ks) { const f32x4 g0 = *(const f32x4*)(qg + ks * 16 + h * 8), g1 = *(const f32x4*)(qg + ks * 16 + h * 8 + 4);
#pragma unroll
            for (int j = 0; j < 8; ++j) qv[ks][j] *= (rstd * (0.08838834764831845f * LOG2E)) * (j < 4 ? g0[j & 3] : g1[j & 3]); }
        if (cache_b >= 0) { const int t = (qtok - NPROMPT) & 4095; const f32x2* rope = (const f32x2*)(p.ws + WS_ROPE0);
#pragma unroll
            for (int kp = 0; kp < 4; ++kp) { const int k1 = (kp >> 1) * 4 + (kp & 1), k2 = k1 + 2;
                const int pos = kp < 2 ? (t >> 6) : (t & 63); const f32x4* rp = (const f32x4*)(rope + pos * 32 + 16 * (k1 & 1) + 8 * h);
#pragma unroll
                for (int q = 0; q < 4; ++q) { const f32x4 cs = rp[q];
                    { const float a = qv[k1][2 * q], b = qv[k2][2 * q]; qv[k1][2 * q] = a * cs[0] - b * cs[1]; qv[k2][2 * q] = a * cs[1] + b * cs[0]; }
                    { const float a = qv[k1][2 * q + 1], b = qv[k2][2 * q + 1]; qv[k1][2 * q + 1] = a * cs[2] - b * cs[3]; qv[k2][2 * q + 1] = a * cs[3] + b * cs[2]; } } } }
#pragma unroll
        for (int ks = 0; ks < 8; ++ks) qf[ks] = __builtin_bit_cast(bf16x8, pack8(qv[ks]));
    }
    f32x16 O[4];
#pragma unroll
    for (int dt = 0; dt < 4; ++dt)
#pragma unroll
        for (int r = 0; r < 16; ++r) O[dt][r] = 0.f;
    float m_run = 0.f, l_run = 0.f;
    const u16* kc = (const u16*)(p.ws + WS_CK0) + (size_t)(cache_b < 0 ? 0 : cache_b) * 256 * 256 + kvh * 128;
    const u16* vc = (const u16*)(p.ws + WS_CV0) + (size_t)(cache_b < 0 ? 0 : cache_b) * 256 * 256 + kvh * 128;
    attn_core<128, true>(lds, qf, z + (size_t)ktok0 * LD0 + Z0_K + kvh * 128, z + (size_t)ktok0 * LD0 + Z0_V + kvh * 128, LD0, n_own,
                   kc, vc, 256, cache_b < 0 ? 0 : 4, 0, 1.f, O, m_run, l_run);
    const float inv = 1.f / l_run;
    LAS unsigned char* yb = lds + wave * 8704 + l31 * 272;
#pragma unroll
    for (int dt = 0; dt < 4; ++dt)
#pragma unroll
        for (int rg = 0; rg < 4; ++rg) { const int d0 = dt * 32 + rg * 8 + 4 * h;
            u32x2 o; o.x = pk2(O[dt][rg * 4 + 0] * inv, O[dt][rg * 4 + 1] * inv); o.y = pk2(O[dt][rg * 4 + 2] * inv, O[dt][rg * 4 + 3] * inv);
            *(LAS u32x2*)(yb + d0 * 2) = o; }
    __syncthreads();
    attn_gate_store<256>(lds, z + (size_t)qtok0 * LD0 + Z0_GB + hq * 128, LD0, (u16*)(p.ws + WS_A) + (size_t)qtok0 * DM + 1024 + hq * 128);
    __syncthreads();
}

__device__ __forceinline__ void gate_item(const Params& p, LAS unsigned char* lds, int chunk, int gh) {
    const int tid = threadIdx.x, lane = tid & 63, wave = tid >> 6, h = lane >> 5, l31 = lane & 31;
    const u16* z = (const u16*)(p.ws + WS_Z);
    const int tok0 = chunk * 128;
    LAS unsigned char* VN = lds; LAS unsigned char* WSb = lds + 32768; LAS f32x2* ST = (LAS f32x2*)(lds + 65536);
    {
        const int tk = tid >> 2, part = tid & 3; const u16* src = z + (size_t)(tok0 + tk) * LD0 + Z0_VA + part * 256;
        float s = 0.f, s2 = 0.f;
#pragma unroll 8
        for (int i = 0; i < 32; ++i) { const u32x4 w = *(const u32x4*)(src + i * 8); float f[8]; unpack8(w, f);
#pragma unroll
            for (int e = 0; e < 8; ++e) { s += f[e]; s2 += f[e] * f[e]; } }
        s += __shfl_xor(s, 1); s2 += __shfl_xor(s2, 1); s += __shfl_xor(s, 2); s2 += __shfl_xor(s2, 2);
        const float mu = s * (1.f / 1024.f); const float var = fmaxf(s2 * (1.f / 1024.f) - mu * mu, 0.f);
        if (part == 0) { f32x2 st; st.x = mu; st.y = 1.0f / sqrtf(var + EPS); ST[tk] = st; }
    }
    __syncthreads();
    const int ct = wave >> 1, pt0 = (wave & 1) * 2;
    const unsigned blk = (lane >> 4) & 1, q4 = (lane & 15) >> 2, p2 = lane & 3;
    u16* ycat = (u16*)(p.ws + WS_A);
    for (int g = gh * 4; g < gh * 4 + 4; ++g) {
#pragma unroll
        for (int i = 0; i < 4; ++i) { const int n = tid + 512 * i, row = n >> 4, ch = n & 15;
            const u32x4 w = *(const u32x4*)(z + (size_t)(tok0 + row) * LD0 + Z0_VA + g * 128 + ch * 8); const f32x2 st = ST[row];
            float f[8]; unpack8(w, f);
#pragma unroll
            for (int e = 0; e < 8; ++e) f[e] = (f[e] - st.x) * st.y;
            *(LAS u32x4*)(VN + off_b(row, ch)) = pack8(f);
            const float* wsrc = p.in[12] + (size_t)g * 16384 + row * 128 + ch * 8;
            const f32x4 w0 = *(const f32x4*)wsrc, w1 = *(const f32x4*)(wsrc + 4);
            u32x4 o; o.x = pk2(w0[0], w0[1]); o.y = pk2(w0[2], w0[3]); o.z = pk2(w1[0], w1[1]); o.w = pk2(w1[2], w1[3]);
            *(LAS u32x4*)(WSb + off_b(row, ch)) = o; }
        __syncthreads();
        f32x16 acc[2];
#pragma unroll
        for (int r = 0; r < 16; ++r) { acc[0][r] = 0.f; acc[1][r] = 0.f; }
#pragma unroll
        for (int ks = 0; ks < 8; ++ks) {
            const unsigned a0 = off_b(16 * ks + 8 * h + q4, 4 * ct + 2 * blk + (p2 >> 1)) + 8 * (p2 & 1);
            const unsigned a1 = off_b(16 * ks + 8 * h + 4 + q4, 4 * ct + 2 * blk + (p2 >> 1)) + 8 * (p2 & 1);
            const bf16x8 A = tr_pair(VN + a0, VN + a1);
#pragma unroll
            for (int i = 0; i < 2; ++i) { const bf16x8 B = *(const LAS bf16x8*)(WSb + off_b((pt0 + i) * 32 + l31, 2 * ks + h)); acc[i] = MFMA32(A, B, acc[i]); }
        }
        LAS unsigned char* Yb = lds + 69632;
#pragma unroll
        for (int i = 0; i < 2; ++i) { const int pp = (pt0 + i) * 32 + l31; const float bs = p.in[13][g * 128 + pp];
            LAS unsigned char* yb = Yb + (pt0 + i) * 8704 + l31 * 272;
#pragma unroll
            for (int rg = 0; rg < 4; ++rg) { const int c0 = ct * 32 + rg * 8 + 4 * h;
                u32x2 o; o.x = pk2(acc[i][rg * 4 + 0] + bs, acc[i][rg * 4 + 1] + bs); o.y = pk2(acc[i][rg * 4 + 2] + bs, acc[i][rg * 4 + 3] + bs);
                *(LAS u32x2*)(yb + c0 * 2) = o; } }
        __syncthreads();
#pragma unroll
        for (int i = 0; i < 4; ++i) { const int n = tid + 512 * i, row = n >> 4, c = n & 15;
            const u32x4 sw = *(const LAS u32x4*)(Yb + (row >> 5) * 8704 + (row & 31) * 272 + c * 16);
            const u16* zr = z + (size_t)(tok0 + row) * LD0 + g * 128 + c * 8;
            const u32x4 uw = *(const u32x4*)(zr + Z0_U), gw = *(const u32x4*)(zr + Z0_GA);
            float s[8], u[8], ga[8]; unpack8(sw, s); unpack8(uw, u); unpack8(gw, ga);
#pragma unroll
            for (int e = 0; e < 8; ++e) s[e] = u[e] * s[e] * silu_fast(ga[e]);
            *(u32x4*)(ycat + (size_t)(tok0 + row) * DM + g * 128 + c * 8) = pack8(s); }
        __syncthreads();
    }
}

__device__ __forceinline__ void phase_mix0(const Params& p, LAS unsigned char* lds) {
    for (int it = blockIdx.x; it < 512; it += gridDim.x) {
        int qtok0, hq, ktok0, n_own, cb;
        if (it < 256) {
            const int x = it & 7, i = it >> 3, pair = x & 3, b = pair >> 1, kvh = pair & 1, sub = (x >> 2) * 32 + i;
            hq = kvh * 4 + (sub >> 4); qtok0 = NPROMPT + b * 4096 + (sub & 15) * 256; ktok0 = NPROMPT + b * 4096; n_own = 64; cb = b; }
        else { const int r = it - 256, i = r >> 3; hq = r & 7; qtok0 = i * 256; ktok0 = i * 256; n_own = 4; cb = -1; }
        gqa_item(p, lds, qtok0, hq, ktok0, n_own, cb);
    }
    for (int it = blockIdx.x; it < 256; it += gridDim.x) gate_item(p, lds, it >> 1, it & 1);
}

__device__ __forceinline__ void diff_item(const Params& p, LAS unsigned char* lds, int qtok0, int hd, int ktok0, int n_own, int cache_b, float lam) {
    const int tid = threadIdx.x, lane = tid & 63, wave = tid >> 6, h = lane >> 5, l31 = lane & 31;
    const u16* z = (const u16*)(p.ws + WS_Z);
    const int map = wave & 1, qt = wave >> 1;
    const int qtok = qtok0 + qt * 32 + l31;
    bf16x8 qf[4];
#pragma unroll
    for (int ks = 0; ks < 4; ++ks) qf[ks] = *(const bf16x8*)(z + (size_t)qtok * LD1 + Z1_Q + hd * 128 + map * 64 + ks * 16 + h * 8);
    f32x16 O[4];
#pragma unroll
    for (int dt = 0; dt < 4; ++dt)
#pragma unroll
        for (int r = 0; r < 16; ++r) O[dt][r] = 0.f;
    float m_run = 0.f, l_run = 0.f;
    const u16* kc = (const u16*)(p.ws + WS_CK1) + (size_t)(cache_b < 0 ? 0 : cache_b) * 256 * LDC1 + hd * 128;
    const u16* vc = (const u16*)(p.ws + WS_CV1) + (size_t)(cache_b < 0 ? 0 : cache_b) * 256 * LDC1 + hd * 128;
    attn_core<64, true>(lds, qf, z + (size_t)ktok0 * LD1 + Z1_K + hd * 128, z + (size_t)ktok0 * LD1 + Z1_V + hd * 128, LD1, n_own,
                  kc, vc, LDC1, cache_b < 0 ? 0 : 4, map * 8, 1.f, O, m_run, l_run);
    const float inv = 1.f / l_run;
    LAS float* X = (LAS float*)(lds + qt * 16384);
    if (map == 1) {
        const float s = inv * lam;
#pragma unroll
        for (int dt = 0; dt < 4; ++dt)
#pragma unroll
            for (int r = 0; r < 16; ++r) X[(dt * 16 + r) * 64 + lane] = O[dt][r] * s;
    }
    __syncthreads();
    if (map == 0) {
        float ss = 0.f;
#pragma unroll
        for (int dt = 0; dt < 4; ++dt)
#pragma unroll
            for (int r = 0; r < 16; ++r) { const float o = O[dt][r] * inv - X[(dt * 16 + r) * 64 + lane]; O[dt][r] = o; ss += o * o; }
        ss += __shfl_xor(ss, 32);
        const float rstd = (1.f - LAMBDA_INIT) / sqrtf(ss * (1.f / 128.f) + EPS);
        LAS unsigned char* yb = lds + 65536 + qt * 8704 + l31 * 272;
        const float* sg = p.in[25];
#pragma unroll
        for (int dt = 0; dt < 4; ++dt)
#pragma unroll
            for (int rg = 0; rg < 4; ++rg) { const int d0 = dt * 32 + rg * 8 + 4 * h;
                const f32x4 s4 = *(const f32x4*)(sg + d0);
                u32x2 o; o.x = pk2(O[dt][rg * 4 + 0] * rstd * s4[0], O[dt][rg * 4 + 1] * rstd * s4[1]);
                o.y = pk2(O[dt][rg * 4 + 2] * rstd * s4[2], O[dt][rg * 4 + 3] * rstd * s4[3]);
                *(LAS u32x2*)(yb + d0 * 2) = o; }
    }
    __syncthreads();
    attn_gate_store<128>(lds + 65536, z + (size_t)qtok0 * LD1 + Z1_G + hd * 128, LD1, (u16*)(p.ws + WS_A) + (size_t)qtok0 * DM + hd * 128);
    __syncthreads();
}
__device__ __forceinline__ void phase_mix1(const Params& p, LAS unsigned char* lds) {
    const int lane = threadIdx.x & 63;
    const float d1 = wave_sum(p.in[21][lane] * p.in[22][lane]), d2 = wave_sum(p.in[23][lane] * p.in[24][lane]);
    const float lam = expf(d1) - expf(d2) + LAMBDA_INIT;
    for (int it = blockIdx.x; it < 2048; it += gridDim.x) {
        int qtok0, hd, ktok0, n_own, cb;
        if (it < 1024) {
            const int x = it & 7, i = (it >> 3) & 31, r = it >> 8, pair = r * 8 + x, b = pair >> 4;
            hd = pair & 15; qtok0 = NPROMPT + b * 4096 + i * 128; ktok0 = NPROMPT + b * 4096; n_own = 64; cb = b; }
        else { const int r = it - 1024, i = r >> 5; hd = (r >> 1) & 15; qtok0 = i * 256 + (r & 1) * 128; ktok0 = i * 256; n_own = 4; cb = -1; }
        diff_item(p, lds, qtok0, hd, ktok0, n_own, cb, lam);
    }
}

__device__ __forceinline__ void grid_barrier(unsigned* bar, unsigned k) {
    __syncthreads();
    if (threadIdx.x == 0) {
        __builtin_amdgcn_fence(__ATOMIC_RELEASE, "agent");
        asm volatile("s_waitcnt vmcnt(0) lgkmcnt(0)" ::: "memory");
        const unsigned G = gridDim.x, nsh = G < 8u ? G : 8u, sh = blockIdx.x % nsh, per = (G - sh + nsh - 1) / nsh;
        const unsigned old = __hip_atomic_fetch_add(bar + 64 * (1 + sh), 1u, __ATOMIC_RELAXED, __HIP_MEMORY_SCOPE_AGENT);
        if (old + 1 == k * per) __hip_atomic_fetch_add(bar, 1u, __ATOMIC_RELAXED, __HIP_MEMORY_SCOPE_AGENT);
        while (__hip_atomic_load(bar, __ATOMIC_RELAXED, __HIP_MEMORY_SCOPE_AGENT) < k * nsh) __builtin_amdgcn_s_sleep(1);
        __builtin_amdgcn_fence(__ATOMIC_ACQUIRE, "agent");
        asm volatile("s_waitcnt vmcnt(0) lgkmcnt(0)" ::: "memory");
    }
    __syncthreads();
}

__global__ __launch_bounds__(512, 2) void mega_fwd(Params p) {
    extern __shared__ __attribute__((aligned(16))) unsigned char smem[];
    LAS unsigned char* lds = (LAS unsigned char*)smem;
    cg::grid_group grid = cg::this_grid();
#define PH_ON(n) (p.ph_lo <= (n) && (n) < p.ph_hi)
#define PH_SYNC(n) do { if (p.ph_lo <= (n) && (n) + 1 < p.ph_hi) { bar_target += 1; grid_barrier(bar_ctr, bar_target); } } while (0)
    unsigned* bar_ctr = (unsigned*)(p.ws + WS_BAR); unsigned bar_target = 0;
    if (p.ph_lo < 0) grid.sync();
#define GEMM_IN(WOFF, NN, LDZ) do { pg8::Gemm g; g.A = (const u16*)(p.ws + WS_A); g.Bt = (const u16*)(p.ws + (WOFF)); g.M = NTOK; g.N = (NN); g.K = DM; \
        pg8::StaticOrder S; S.init(g.M, g.N, gridDim.x, blockIdx.x); pg8::EpiBf16 E; E.O = (u16*)(p.ws + WS_Z); E.ldc = (LDZ); pg8::gemm_phase(lds, g, S, E); } while (0)
#define GEMM_OUT(WOFF, XA, XB, LAYER) do { pg8::Gemm g; g.A = (const u16*)(p.ws + WS_A); g.Bt = (const u16*)(p.ws + (WOFF)); g.M = NTOK; g.N = DM; g.K = DM; \
        pg8::StaticOrder S; S.init(g.M, g.N, gridDim.x, blockIdx.x); pg8::EpiResid E; E.xa = (XA); E.xb = (XB); E.xout = p.out + OUT_Y; \
        E.gate = (const float*)(p.ws + WS_MOD) + (LAYER) * 3 * 6144 + 4096; pg8::gemm_phase(lds, g, S, E); } while (0)
    if (PH_ON(0)) phase_prep(p, lds);
    PH_SYNC(0);
    if (PH_ON(1)) phase_norm<0, false>(p, 0, lds);
    PH_SYNC(1);
    if (PH_ON(2)) { pg8::Gemm g; g.A = (const u16*)(p.ws + WS_A); g.Bt = (const u16*)(p.ws + WS_WIN0); g.M = NTOK; g.N = IN0; g.K = DM;
        pg8::StaticOrder S; S.init(g.M, g.N, gridDim.x, blockIdx.x); pg8::EpiIn0 E; E.O = (u16*)(p.ws + WS_Z); E.ldc = LD0; E.outv = p.out + OUT_V0; pg8::gemm_phase(lds, g, S, E);
        { const int nwg = (NTOK / 256) * (IN0 / 256), G = (int)gridDim.x, rem = nwg % G;
          if (rem == 0) prep_w1(p, lds, blockIdx.x, G); else if ((int)blockIdx.x >= rem) prep_w1(p, lds, blockIdx.x - rem, G - rem); } }
    PH_SYNC(2);
    if (PH_ON(3)) phase_post0(p);
    PH_SYNC(3);
    if (PH_ON(4)) phase_mix0(p, lds);
    PH_SYNC(4);
    if (PH_ON(5)) GEMM_IN(WS_WOUT0, DM, DM);
    PH_SYNC(5);
    if (PH_ON(6)) phase_norm<0, true>(p, 1, lds);
    PH_SYNC(6);
    if (PH_ON(7)) { pg8::Gemm g; g.A = (const u16*)(p.ws + WS_A); g.Bt = (const u16*)(p.ws + WS_WIN1); g.M = NTOK; g.N = IN1; g.K = DM;
        pg8::StaticOrder S; S.init(g.M, g.N, gridDim.x, blockIdx.x); pg8::EpiIn1 E; E.O = (u16*)(p.ws + WS_Z); E.ldc = LD1;
        E.outk = p.out + OUT_K1; E.outv = p.out + OUT_V1; E.rope = (const f32x2*)(p.ws + WS_ROPE1); pg8::gemm_phase(lds, g, S, E); }
    PH_SYNC(7);
    if (PH_ON(9)) phase_mix1(p, lds);
    PH_SYNC(9);
    if (PH_ON(10)) GEMM_IN(WS_WOUT1, DM, DM);
    PH_SYNC(10);
    if (PH_ON(11)) phase_norm<1, true>(p, 1, lds);
}

extern "C" void kernel_launch(void* const* d_in, const int* in_sizes, int n_in, void* d_out, int out_size, void* d_ws, size_t ws_size, hipStream_t stream) {
    static int grid = 0;
    if (grid == 0) {
        if (n_in != 28 || ws_size < WS_END) { fprintf(stderr, "kernel_launch: unexpected n_in %d or ws_size %zu (< %zu)\n", n_in, ws_size, (size_t)WS_END); grid = -1; return; }
        int dev = 0, cus = 0, per_cu = 0;
        hipGetDevice(&dev);
        hipDeviceGetAttribute(&cus, hipDeviceAttributeMultiprocessorCount, dev);
        hipFuncSetAttribute((const void*)mega_fwd, hipFuncAttributeMaxDynamicSharedMemorySize, LDS_BYTES);
        hipOccupancyMaxActiveBlocksPerMultiprocessor(&per_cu, (const void*)mega_fwd, 512, LDS_BYTES);
        if (per_cu < 1) per_cu = 1;
        grid = cus * per_cu;
        if (grid > 256) grid = 256;
    }
    if (grid < 0) return;
    if (hipMemsetAsync((char*)d_ws + WS_BAR, 0, 4096, stream) != hipSuccess) { fprintf(stderr, "kernel_launch: memset of the barrier word failed\n"); return; }
    Params p{};
    for (int i = 0; i < 28; ++i) p.in[i] = (const float*)d_in[i];
    p.out = (float*)d_out; p.ws = (unsigned char*)d_ws; p.ph_lo = 0; p.ph_hi = 12;
    void* args[] = {&p};
    hipError_t e = hipLaunchCooperativeKernel((const void*)mega_fwd, dim3(grid), dim3(512), args, LDS_BYTES, stream);
    if (e != hipSuccess) fprintf(stderr, "cooperative launch failed: %s (grid %d)\n", hipGetErrorString(e), grid);
}
```
